# Optimizing an MI355X kernel written in HIP

```python
import math
import jax, jax.numpy as jnp
from jax import lax
import numpy as np

D_MODEL = 1024
BATCH = 2
SEQ = 8192
DEPTH = 2

CHUNK = 64
N_MIXERS = 2
N_A = (DEPTH + 1) // 2
N_B = DEPTH // 2

D_RNN = D_MODEL
RG_BLOCKS = 4
RG_BW = D_RNN // RG_BLOCKS
CONV_W = 4
RG_C = 8.0

SB_HEADS = 16
SB_HEAD_DIM = D_MODEL // SB_HEADS
Q_BLOCK = 128

D_FF = int(math.ceil(8 * D_MODEL / 3 / 256) * 256)

RMS_EPS = 1e-6

kernel_name = "hybrid_rglru_stickbreaking_trunk"


def _rmsnorm(x, g):
    x32 = x.astype(jnp.float32)
    y = x32 * lax.rsqrt(jnp.mean(x32 * x32, axis=-1, keepdims=True) + RMS_EPS)
    return (y * g.astype(jnp.float32)).astype(x.dtype)


def _causal_depthwise_conv(x, w, b):
    c = x.shape[-1]
    y = lax.conv_general_dilated(
        x, w.astype(x.dtype)[:, None, :], window_strides=(1,),
        padding=[(CONV_W - 1, 0)], dimension_numbers=("NWC", "WIO", "NWC"),
        feature_group_count=c)
    return y + b.astype(x.dtype)


def _linear_scan(a, u):
    def combine(l, r):
        a_l, b_l = l
        a_r, b_r = r
        return a_l * a_r, a_r * b_l + b_r
    _, h = lax.associative_scan(combine, (a, u), axis=1)
    return h


def _rglru_mixer(h, w_in, conv_w, conv_b, w_r, b_r, w_i, b_i, lam, w_out):
    bsz, s, _ = h.shape
    proj = h @ w_in.astype(h.dtype)
    gate_br, x_br = proj[..., :D_RNN], proj[..., D_RNN:]
    gate = jax.nn.gelu(gate_br, approximate=True)
    xc = _causal_depthwise_conv(x_br, conv_w, conv_b)
    xg = xc.reshape(bsz, s, RG_BLOCKS, RG_BW).astype(jnp.float32)
    r = jax.nn.sigmoid(jnp.einsum("bsnc,ncd->bsnd", xg, w_r.astype(jnp.float32)).reshape(bsz, s, D_RNN)
                       + b_r.astype(jnp.float32))
    i = jax.nn.sigmoid(jnp.einsum("bsnc,ncd->bsnd", xg, w_i.astype(jnp.float32)).reshape(bsz, s, D_RNN)
                       + b_i.astype(jnp.float32))
    log_a = RG_C * r * jax.nn.log_sigmoid(lam.astype(jnp.float32))
    a = jnp.exp(log_a)
    mult = jnp.sqrt(jnp.maximum(-jnp.expm1(2.0 * log_a), 0.0))
    u = mult * (i * xc.astype(jnp.float32))
    hs = _linear_scan(a, u)
    y = (hs * gate.astype(jnp.float32)).astype(h.dtype)
    return y @ w_out.astype(h.dtype)


def _stick_breaking_attention(q, k, v):
    bsz, nh, s, dh = q.shape
    nq = s // Q_BLOCK
    scale = 1.0 / math.sqrt(dh)
    k32 = k.astype(jnp.float32)
    v32 = v.astype(jnp.float32)
    key_pos = jnp.arange(s)
    q_blocks = q.reshape(bsz, nh, nq, Q_BLOCK, dh).transpose(2, 0, 1, 3, 4)
    starts = jnp.arange(nq) * Q_BLOCK

    def block(args):
        qb, start = args
        z = jnp.einsum("bhqd,bhkd->bhqk", qb.astype(jnp.float32), k32) * scale
        q_pos = start + jnp.arange(Q_BLOCK)
        mask = key_pos[None, :] < q_pos[:, None]
        log_beta = jax.nn.log_sigmoid(z)
        log_1m = jnp.where(mask, jax.nn.log_sigmoid(-z), 0.0)
        suffix = lax.cumsum(log_1m, axis=3, reverse=True) - log_1m
        wts = jnp.where(mask, jnp.exp(log_beta + suffix), 0.0)
        return jnp.einsum("bhqk,bhkd->bhqd", wts, v32)

    out = lax.map(block, (q_blocks, starts))
    return out.transpose(1, 2, 0, 3, 4).reshape(bsz, nh, s, dh).astype(q.dtype)


def _sb_mixer(h, w_qkv, w_out):
    bsz, s, _ = h.shape
    qkv = (h @ w_qkv.astype(h.dtype)).reshape(bsz, s, 3, SB_HEADS, SB_HEAD_DIM)
    qkv = qkv.transpose(2, 0, 3, 1, 4)
    o = _stick_breaking_attention(qkv[0], qkv[1], qkv[2])
    o = o.transpose(0, 2, 1, 3).reshape(bsz, s, D_MODEL)
    return o @ w_out.astype(h.dtype)


def _swiglu(h, w_gate, w_up, w_down):
    g = h @ w_gate.astype(h.dtype)
    u = h @ w_up.astype(h.dtype)
    return (jax.nn.silu(g) * u) @ w_down.astype(h.dtype)


def setup_inputs(seed: int = 0) -> dict:
    key = jax.random.key(seed)
    ks = jax.random.split(key, 20)
    f32 = jnp.float32

    def nrm(k, shape, fan_in):
        return jax.random.normal(k, shape, f32) * (fan_in ** -0.5)

    a0 = jax.random.uniform(ks[10], (N_A, D_RNN), f32, 0.9, 0.999)
    base = a0 ** (1.0 / RG_C)
    lam = jnp.log(base) - jnp.log1p(-base)

    return {
        "x": jax.random.normal(ks[0], (BATCH, SEQ, D_MODEL), f32),
        "norm_mix_g": 1.0 + 0.02 * jax.random.normal(ks[1], (DEPTH, D_MODEL), f32),
        "norm_ffn_g": 1.0 + 0.02 * jax.random.normal(ks[2], (DEPTH, D_MODEL), f32),
        "a_w_in": nrm(ks[3], (N_A, D_MODEL, 2 * D_RNN), D_MODEL),
        "a_conv_w": nrm(ks[4], (N_A, CONV_W, D_RNN), CONV_W),
        "a_conv_b": 0.01 * jax.random.normal(ks[5], (N_A, D_RNN), f32),
        "a_w_r": nrm(ks[6], (N_A, RG_BLOCKS, RG_BW, RG_BW), RG_BW),
        "a_b_r": 0.01 * jax.random.normal(ks[7], (N_A, D_RNN), f32),
        "a_w_i": nrm(ks[8], (N_A, RG_BLOCKS, RG_BW, RG_BW), RG_BW),
        "a_b_i": 0.01 * jax.random.normal(ks[9], (N_A, D_RNN), f32),
        "a_lambda": lam,
        "a_w_out": nrm(ks[11], (N_A, D_RNN, D_MODEL), D_RNN),
        "b_w_qkv": nrm(ks[12], (N_B, D_MODEL, 3 * D_MODEL), D_MODEL),
        "b_w_out": nrm(ks[13], (N_B, D_MODEL, D_MODEL), D_MODEL),
        "ffn_w_gate": nrm(ks[14], (DEPTH, D_MODEL, D_FF), D_MODEL),
        "ffn_w_up": nrm(ks[15], (DEPTH, D_MODEL, D_FF), D_MODEL),
        "ffn_w_down": nrm(ks[16], (DEPTH, D_FF, D_MODEL), D_FF),
        "final_g": 1.0 + 0.02 * jax.random.normal(ks[17], (D_MODEL,), f32),
    }


def reference(x, norm_mix_g, norm_ffn_g, a_w_in, a_conv_w, a_conv_b, a_w_r, a_b_r,
              a_w_i, a_b_i, a_lambda, a_w_out, b_w_qkv, b_w_out,
              ffn_w_gate, ffn_w_up, ffn_w_down, final_g):
    for layer in range(DEPTH):
        h = _rmsnorm(x, norm_mix_g[layer])
        if layer % N_MIXERS == 0:
            j = layer // N_MIXERS
            mix = _rglru_mixer(h, a_w_in[j], a_conv_w[j], a_conv_b[j], a_w_r[j], a_b_r[j],
                               a_w_i[j], a_b_i[j], a_lambda[j], a_w_out[j])
        else:
            j = layer // N_MIXERS
            mix = _sb_mixer(h, b_w_qkv[j], b_w_out[j])
        x = x + mix
        h = _rmsnorm(x, norm_ffn_g[layer])
        x = x + _swiglu(h, ffn_w_gate[layer], ffn_w_up[layer], ffn_w_down[layer])
    return _rmsnorm(x, final_g)
```

```cpp
#include <hip/hip_runtime.h>
#include <hip/hip_cooperative_groups.h>
#include <cstdio>
#include <cstdint>
namespace cg = cooperative_groups;

#define LAS __attribute__((address_space(3)))
typedef unsigned short bf16_t;
typedef short bf16x8 __attribute__((ext_vector_type(8)));
typedef short s16x4 __attribute__((ext_vector_type(4)));
typedef float f32x2 __attribute__((ext_vector_type(2)));
typedef float f32x4 __attribute__((ext_vector_type(4)));
typedef float f32x16 __attribute__((ext_vector_type(16)));
typedef unsigned u32x2 __attribute__((ext_vector_type(2)));
typedef unsigned u32x4 __attribute__((ext_vector_type(4)));
typedef __bf16 bf16v2 __attribute__((ext_vector_type(2)));

constexpr int BATCH = 2, SEQ = 8192, DM = 1024, MTOK = BATCH * SEQ, DFF = 2816, NHEAD = 16, HDIM = 64;
constexpr float RMS_EPS = 1e-6f;
constexpr float LOG2E = 1.4426950408889634f;

__device__ __forceinline__ unsigned pk_bf16(float lo, float hi) { f32x2 v = {lo, hi}; return __builtin_bit_cast(unsigned, __builtin_convertvector(v, bf16v2)); }
typedef _Float16 f16v2 __attribute__((ext_vector_type(2)));
__device__ __forceinline__ unsigned pk_f16(float lo, float hi) { f32x2 v = {lo, hi}; return __builtin_bit_cast(unsigned, __builtin_convertvector(v, f16v2)); }
__device__ __forceinline__ f32x2 unpk_f16(unsigned w) { return __builtin_convertvector(__builtin_bit_cast(f16v2, w), f32x2); }
__device__ __forceinline__ float bf_lo(unsigned w) { return __uint_as_float(w << 16); }
__device__ __forceinline__ float bf_hi(unsigned w) { return __uint_as_float(w & 0xffff0000u); }
__device__ __forceinline__ float fast_sigmoid(float v) { return __builtin_amdgcn_rcpf(1.0f + __builtin_amdgcn_exp2f(-v * LOG2E)); }
__device__ __forceinline__ float gelu_tanh(float x) { const float y2 = x * (1.5957691216057308f + 0.07135481627f * x * x); return x * __builtin_amdgcn_rcpf(1.0f + __builtin_amdgcn_exp2f(-y2 * LOG2E)); }
__device__ __forceinline__ int fresh_lane() { int l; asm volatile("v_mbcnt_lo_u32_b32 %0, -1, 0\n\tv_mbcnt_hi_u32_b32 %0, -1, %0" : "=v"(l)); return l; }
__device__ __forceinline__ float wave_sum(float v) {
#pragma unroll
    for (int o = 1; o < 64; o <<= 1) v += __shfl_xor(v, o);
    return v;
}
__device__ __forceinline__ float row_rs(const float* ssp, int row) { const f32x4 s = *(const f32x4*)(ssp + (size_t)row * 4); return rsqrtf(((s[0] + s[1]) + (s[2] + s[3])) * (1.0f / DM) + RMS_EPS); }

namespace pg8 {
#define PG8_LAS __attribute__((address_space(3)))
constexpr int BM = 256, BK = 64, HALF = 128, HTB = HALF * BK * 2  , STAGE_BYTES = 8 * HTB, NXCD = 8, WGM = 8;

__host__ __device__ __forceinline__ int lds_byte(int r, int c) { const int st = (r >> 4) * 2 + (c >> 5), rr = r & 15, cc = c & 31, ob = rr * 64 + cc * 2; return st * 1024 + (ob ^ (((ob >> 9) & 1) << 5)); }
__host__ __device__ __forceinline__ void stage_rc(int b, int& R, int& C) { const int st = b / 1024, sb = b % 1024, swz = sb ^ (((sb >> 9) & 1) << 5); R = (st >> 1) * 16 + swz / 64; C = (st & 1) * 32 + (swz % 64) / 2; }
__host__ __device__ __forceinline__ int perm32(int rho) { const int n = rho >> 4, i = rho & 15; return 8 * (i >> 2) + 4 * n + (i & 3); }

struct Unit { int pm, pn; };
struct Gemm { const bf16_t* A; const bf16_t* Bt; int M, N, K, lda, ldb, bd; const bf16_t* A2 = nullptr; const bf16_t* B2 = nullptr; int swap_pn = 1 << 30; };

struct StaticOrder {
    int nM, nN, nwg, G, c;
    __host__ __device__ void init(int M, int N, int G_, int c_) { nM = M / BM; nN = N / BM; nwg = nM * nN; G = G_; c = c_; }
    __host__ __device__ bool next(int i, Unit& u) const {
        const long L = (long)i * G + c; if (L >= nwg) return false;
        int wgid = (int)L; { const int q = nwg / NXCD, r = nwg % NXCD, xcd = wgid % NXCD, off = wgid / NXCD; wgid = (xcd < r ? xcd * (q + 1) : r * (q + 1) + (xcd - r) * q) + off; }
        const int nig = WGM * nN, gid = wgid / nig, fm = gid * WGM, gsz = (nM - fm) < WGM ? (nM - fm) : WGM;
        u.pm = fm + ((wgid % nig) % gsz); u.pn = (wgid % nig) / gsz; return true;
    }
    __device__ __forceinline__ void a_ready(const Unit&) const {}
    __device__ __forceinline__ void done(const Unit&) const {}
};

typedef f32x4 AccT[2][2][4][2];

struct EpiInProj {
    static constexpr bool PERM = true, AFTER_DRAIN = false, ACC_INIT = false;
    bf16_t* gate; bf16_t* xbr; const LAS float* rst; int row_base;
    __device__ __forceinline__ void operator()(const AccT& acc, const Unit& u, int wr, int wc, int fr, int fq) const {
        const bool isgate = u.pn < 4;
        bf16_t* base = isgate ? gate : xbr;
        const int row0 = u.pm * BM + wr * 64 + fr, col0 = (u.pn & 3) * BM + wc * 32 + 8 * fq;
#pragma unroll
        for (int ai = 0; ai < 2; ++ai)
#pragma unroll
            for (int m = 0; m < 4; ++m) { const int row = row0 + ai * HALF + m * 16; const float rs = rst[row - row_base]; bf16_t* rowp = base + (size_t)row * DM + col0;
#pragma unroll
                for (int bj = 0; bj < 2; ++bj) { f32x4 v0 = acc[ai][bj][m][0] * rs, v1 = acc[ai][bj][m][1] * rs;
                    if (isgate) {
#pragma unroll
                        for (int e = 0; e < 4; ++e) { v0[e] = gelu_tanh(v0[e]); v1[e] = gelu_tanh(v1[e]); } }
                    u32x4 w; w.x = pk_bf16(v0[0], v0[1]); w.y = pk_bf16(v0[2], v0[3]); w.z = pk_bf16(v1[0], v1[1]); w.w = pk_bf16(v1[2], v1[3]);
                    *(u32x4*)(rowp + bj * HALF) = w; } }
    }
};

struct EpiGates {
    static constexpr bool PERM = true, AFTER_DRAIN = false, ACC_INIT = false;
    const bf16_t* xc; const float* b_r; const float* b_i; const float* c8t; unsigned* au_out;
    __device__ __forceinline__ void operator()(const AccT& acc, const Unit& u, int wr, int wc, int fr, int fq) const {
        const int ch0 = (u.pn >> 1) * 256 + (u.pn & 1) * 128 + wc * 32 + 8 * fq, row0 = u.pm * BM + wr * 64 + fr;
        f32x4 br[2], bi[2], c8[2];
#pragma unroll
        for (int n = 0; n < 2; ++n) { br[n] = *(const f32x4*)(b_r + ch0 + 4 * n); bi[n] = *(const f32x4*)(b_i + ch0 + 4 * n); c8[n] = *(const f32x4*)(c8t + ch0 + 4 * n); }
#pragma unroll
        for (int ai = 0; ai < 2; ++ai)
#pragma unroll
            for (int m = 0; m < 4; ++m) { const unsigned off = (unsigned)(row0 + ai * HALF + m * 16) * DM + ch0;
                const u32x4 xw = *(const u32x4*)(xc + off);
                const float xv[8] = {bf_lo(xw.x), bf_hi(xw.x), bf_lo(xw.y), bf_hi(xw.y), bf_lo(xw.z), bf_hi(xw.z), bf_lo(xw.w), bf_hi(xw.w)};
                u32x4 pk[2];
#pragma unroll
                for (int n = 0; n < 2; ++n)
#pragma unroll
                    for (int e = 0; e < 4; ++e) {
                        const float rr = fast_sigmoid(acc[ai][0][m][n][e] + br[n][e]), ii = fast_sigmoid(acc[ai][1][m][n][e] + bi[n][e]);
                        const float la = c8[n][e] * rr, a = __builtin_amdgcn_exp2f(la * LOG2E), x2 = 2.0f * la;
                        const float ser = -x2 * (1.0f + x2 * (0.5f + x2 * (0.16666667f + x2 * 0.041666668f)));
                        const float m2 = x2 > -0.06f ? ser : 1.0f - a * a;
                        pk[n][e] = pk_f16(la * (LOG2E * 1024.0f), __builtin_amdgcn_sqrtf(fmaxf(m2, 0.f)) * (ii * xv[4 * n + e])); }
                *(u32x4*)(au_out + off) = pk[0]; *(u32x4*)(au_out + off + 4) = pk[1];
                asm volatile("" ::: "memory"); }
    }
};

struct EpiSwiglu {
    static constexpr bool PERM = true, AFTER_DRAIN = false, ACC_INIT = false;
    bf16_t* hid; const LAS float* rst; int row_base;
    __device__ __forceinline__ void operator()(const AccT& acc, const Unit& u, int wr, int wc, int fr, int fq) const {
        const int row0 = u.pm * BM + wr * 64 + fr, col0 = u.pn * HALF + wc * 32 + 8 * fq;
#pragma unroll
        for (int ai = 0; ai < 2; ++ai)
#pragma unroll
            for (int m = 0; m < 4; ++m) { const int row = row0 + ai * HALF + m * 16; const float rs = rst[row - row_base];
                float hv[8];
#pragma unroll
                for (int n = 0; n < 2; ++n)
#pragma unroll
                    for (int e = 0; e < 4; ++e) { const float g = acc[ai][0][m][n][e] * rs, uu = acc[ai][1][m][n][e] * rs; hv[4 * n + e] = g * fast_sigmoid(g) * uu; }
                u32x4 w; w.x = pk_bf16(hv[0], hv[1]); w.y = pk_bf16(hv[2], hv[3]); w.z = pk_bf16(hv[4], hv[5]); w.w = pk_bf16(hv[6], hv[7]);
                *(u32x4*)(hid + (size_t)row * DFF + col0) = w; }
    }
};

struct EpiQK {
    static constexpr bool PERM = true, AFTER_DRAIN = false, ACC_INIT = false;
    bf16_t* q; bf16_t* k; const LAS float* rst; int row_base; float qscale;
    __device__ __forceinline__ void operator()(const AccT& acc, const Unit& u, int wr, int wc, int fr, int fq) const {
        const bool isq = u.pn < 4; bf16_t* base = isq ? q : k; const float sc = isq ? qscale : 1.0f;
        const int row0 = u.pm * BM + wr * 64 + fr, col0 = (u.pn & 3) * BM + wc * 32 + 8 * fq;
#pragma unroll
        for (int ai = 0; ai < 2; ++ai)
#pragma unroll
            for (int m = 0; m < 4; ++m) { const int row = row0 + ai * HALF + m * 16; const float rs = rst[row - row_base] * sc;
                const unsigned b = (unsigned)row >> 13, t = (unsigned)row & 8191u;
#pragma unroll
                for (int bj = 0; bj < 2; ++bj) { const f32x4 v0 = acc[ai][bj][m][0] * rs, v1 = acc[ai][bj][m][1] * rs;
                    const unsigned col = col0 + bj * HALF, hd = col >> 6, d0 = col & 63u;
                    const unsigned off = ((((b * NHEAD + hd) * 256u + (t >> 5)) * 4u + (d0 >> 4)) * 64u + ((d0 >> 3) & 1u) * 32u + (t & 31u)) * 8u;
                    u32x4 w; w.x = pk_bf16(v0[0], v0[1]); w.y = pk_bf16(v0[2], v0[3]); w.z = pk_bf16(v1[0], v1[1]); w.w = pk_bf16(v1[2], v1[3]);
                    *(u32x4*)(base + off) = w; } }
    }
};

struct EpiVT {
    static constexpr bool PERM = true, AFTER_DRAIN = false, ACC_INIT = false;
    bf16_t* vt; const LAS float* rst; int row_base;
    __device__ __forceinline__ void operator()(const AccT& acc, const Unit& u, int wr, int wc, int fr, int fq) const {
        const int row0 = u.pm * BM + wr * 64 + fr, tok0 = u.pn * BM + wc * 32 + 8 * fq;
        float rsv[2][8];
#pragma unroll
        for (int bj = 0; bj < 2; ++bj)
#pragma unroll
            for (int j = 0; j < 8; ++j) rsv[bj][j] = rst[tok0 + bj * HALF + j - row_base];
#pragma unroll
        for (int ai = 0; ai < 2; ++ai)
#pragma unroll
            for (int m = 0; m < 4; ++m) { const unsigned row = row0 + ai * HALF + m * 16, hd = row >> 6, d = row & 63u;
#pragma unroll
                for (int bj = 0; bj < 2; ++bj) { const f32x4 a0 = acc[ai][bj][m][0], a1 = acc[ai][bj][m][1];
                    const unsigned tok = tok0 + bj * HALF, b = tok >> 13, t = tok & 8191u;
                    const unsigned off = (((((b * NHEAD + hd) * 256u + (t >> 5)) * 2u + (d >> 5)) * 2u + ((t >> 4) & 1u)) * 64u + (d & 31u)) * 8u + 4u * ((t >> 3) & 1u);
                    u32x2 w0, w1; w0.x = pk_bf16(a0[0] * rsv[bj][0], a0[1] * rsv[bj][1]); w0.y = pk_bf16(a0[2] * rsv[bj][2], a0[3] * rsv[bj][3]);
                    w1.x = pk_bf16(a1[0] * rsv[bj][4], a1[1] * rsv[bj][5]); w1.y = pk_bf16(a1[2] * rsv[bj][6], a1[3] * rsv[bj][7]);
                    *(u32x2*)(vt + off) = w0; *(u32x2*)(vt + off + 32 * 8) = w1; } }
    }
};

struct EpiQKV {
    static constexpr bool PERM = true, AFTER_DRAIN = false, ACC_INIT = false;
    EpiQK qk; EpiVT vt;
    __device__ __forceinline__ void operator()(const AccT& acc, const Unit& u, int wr, int wc, int fr, int fq) const {
        if (u.pn >= 8) { const Unit ut{u.pn - 8, u.pm}; vt(acc, ut, wr, wc, fr, fq); } else qk(acc, u, wr, wc, fr, fq);
    }
};

__device__ __forceinline__ void acc_from_xb(AccT& acc, const bf16_t* xb, const Unit& u, int wr, int wc, int fr, int fq) {
    const unsigned off0 = (unsigned)(u.pm * BM + wr * 64 + fr) * DM + u.pn * BM + wc * 32 + 8 * fq;
#pragma unroll
    for (int ai = 0; ai < 2; ++ai)
#pragma unroll
        for (int m = 0; m < 4; ++m)
#pragma unroll
            for (int bj = 0; bj < 2; ++bj) { const u32x4 w = *(const u32x4*)(xb + off0 + (unsigned)(ai * HALF + m * 16) * DM + bj * HALF);
                acc[ai][bj][m][0] = (f32x4){bf_lo(w.x), bf_hi(w.x), bf_lo(w.y), bf_hi(w.y)}; acc[ai][bj][m][1] = (f32x4){bf_lo(w.z), bf_hi(w.z), bf_lo(w.w), bf_hi(w.w)}; }
}
__device__ __forceinline__ void tile_row_ss(const AccT& acc, PG8_LAS float* P, int wr, int wc, int fr, int fq) {
#pragma unroll
    for (int ai = 0; ai < 2; ++ai)
#pragma unroll
        for (int m = 0; m < 4; ++m) { float ss = 0.f;
#pragma unroll
            for (int bj = 0; bj < 2; ++bj) { const f32x4 v0 = acc[ai][bj][m][0], v1 = acc[ai][bj][m][1];
                ss += (v0[0] * v0[0] + v0[1] * v0[1]) + (v0[2] * v0[2] + v0[3] * v0[3]) + (v1[0] * v1[0] + v1[1] * v1[1]) + (v1[2] * v1[2] + v1[3] * v1[3]); }
            ss += __shfl_xor(ss, 16); ss += __shfl_xor(ss, 32);
            if (fq == 0) P[(ai * HALF + wr * 64 + m * 16 + fr) * 4 + wc] = ss; }
}
struct EpiResid {
    static constexpr bool PERM = true, AFTER_DRAIN = true, ACC_INIT = true;
    bf16_t* xb; float* ssp;
    __device__ __forceinline__ void init(AccT& acc, const Unit& u, int wr, int wc, int fr, int fq) const { acc_from_xb(acc, xb, u, wr, wc, fr, fq); }
    __device__ __forceinline__ void fused(AccT& acc, const Unit& u, int wr, int wc, int fr, int fq, PG8_LAS unsigned char* lds, int wid, int lane) const {
        PG8_LAS float* P = (PG8_LAS float*)lds;
        const unsigned off0 = (unsigned)(u.pm * BM + wr * 64 + fr) * DM + u.pn * BM + wc * 32 + 8 * fq;
#pragma unroll
        for (int ai = 0; ai < 2; ++ai)
#pragma unroll
            for (int m = 0; m < 4; ++m)
#pragma unroll
                for (int bj = 0; bj < 2; ++bj) { const f32x4 v0 = acc[ai][bj][m][0], v1 = acc[ai][bj][m][1];
                    u32x4 w; w.x = pk_bf16(v0[0], v0[1]); w.y = pk_bf16(v0[2], v0[3]); w.z = pk_bf16(v1[0], v1[1]); w.w = pk_bf16(v1[2], v1[3]);
                    *(u32x4*)(xb + off0 + (unsigned)(ai * HALF + m * 16) * DM + bj * HALF) = w; }
        tile_row_ss(acc, P, wr, wc, fr, fq);
        asm volatile("s_waitcnt lgkmcnt(0)" ::: "memory"); __builtin_amdgcn_s_barrier(); asm volatile("" ::: "memory");
        const int tid = wid * 64 + lane;
        if (tid < 256) { const f32x4 p = *(const PG8_LAS f32x4*)(P + tid * 4); ssp[(size_t)(u.pm * BM + tid) * 4 + u.pn] = (p[0] + p[1]) + (p[2] + p[3]); }
    }
};
struct EpiFinal {
    static constexpr bool PERM = false, AFTER_DRAIN = true, ACC_INIT = true;
    const bf16_t* xb; float* ssp; unsigned* cnt; const float* g; float* out;
    __device__ __forceinline__ void init(AccT& acc, const Unit& u, int wr, int wc, int fr, int fq) const {
        const unsigned off0 = (unsigned)(u.pm * BM + wr * 64 + fr) * DM + u.pn * BM + wc * 32 + 4 * fq;
#pragma unroll
        for (int ai = 0; ai < 2; ++ai)
#pragma unroll
            for (int m = 0; m < 4; ++m)
#pragma unroll
                for (int bj = 0; bj < 2; ++bj)
#pragma unroll
                    for (int n = 0; n < 2; ++n) { const u32x2 w = *(const u32x2*)(xb + off0 + (unsigned)(ai * HALF + m * 16) * DM + bj * HALF + 16 * n);
                        acc[ai][bj][m][n] = (f32x4){bf_lo(w.x), bf_hi(w.x), bf_lo(w.y), bf_hi(w.y)}; }
    }
    __device__ __forceinline__ void fused(AccT& acc, const Unit& u, int wr, int wc, int fr, int fq, PG8_LAS unsigned char* lds, int wid, int lane) const {
        PG8_LAS float* P = (PG8_LAS float*)lds;
        PG8_LAS float* RS = (PG8_LAS float*)(lds + 4096);
        tile_row_ss(acc, P, wr, wc, fr, fq);
        asm volatile("s_waitcnt lgkmcnt(0)" ::: "memory"); __builtin_amdgcn_s_barrier(); asm volatile("" ::: "memory");
        const int tid = wid * 64 + lane;
        if (tid < 256) { const f32x4 p = *(const PG8_LAS f32x4*)(P + tid * 4);
            __hip_atomic_store(ssp + (size_t)(u.pm * BM + tid) * 4 + u.pn, (p[0] + p[1]) + (p[2] + p[3]), __ATOMIC_RELAXED, __HIP_MEMORY_SCOPE_AGENT); }
        asm volatile("s_waitcnt vmcnt(0)" ::: "memory");
        unsigned* c = cnt + 64 * u.pm;
        if (lane == 0) __hip_atomic_fetch_add(c, 1u, __ATOMIC_RELAXED, __HIP_MEMORY_SCOPE_AGENT);
        if (wid == 0) {
            unsigned sp = 0;
            while ((unsigned)__builtin_amdgcn_readfirstlane(__hip_atomic_load(c, __ATOMIC_RELAXED, __HIP_MEMORY_SCOPE_AGENT)) < 32u) { __builtin_amdgcn_s_sleep(2); if (++sp > (1u << 24)) break; }
            __builtin_amdgcn_fence(__ATOMIC_ACQUIRE, "agent");
        }
        asm volatile("s_waitcnt vmcnt(0) lgkmcnt(0)" ::: "memory"); __builtin_amdgcn_s_barrier(); asm volatile("" ::: "memory");
        if (tid < 256) { const float* sl = ssp + (size_t)(u.pm * BM + tid) * 4; float s = 0.f;
#pragma unroll
            for (int t = 0; t < 4; ++t) s += __hip_atomic_load(sl + t, __ATOMIC_RELAXED, __HIP_MEMORY_SCOPE_AGENT);
            RS[tid] = rsqrtf(s * (1.0f / DM) + RMS_EPS); }
        asm volatile("s_waitcnt vmcnt(0) lgkmcnt(0)" ::: "memory"); __builtin_amdgcn_s_barrier(); asm volatile("" ::: "memory");
        const int col0 = u.pn * BM + wc * 32 + 4 * fq;
        f32x4 gv[2][2];
#pragma unroll
        for (int bj = 0; bj < 2; ++bj)
#pragma unroll
            for (int n = 0; n < 2; ++n) gv[bj][n] = *(const f32x4*)(g + col0 + bj * HALF + 16 * n);
#pragma unroll
        for (int ai = 0; ai < 2; ++ai)
#pragma unroll
            for (int m = 0; m < 4; ++m) { const int rl = ai * HALF + wr * 64 + m * 16 + fr; const float rs = RS[rl]; float* op = out + (size_t)(u.pm * BM + rl) * DM + col0;
#pragma unroll
                for (int bj = 0; bj < 2; ++bj)
#pragma unroll
                    for (int n = 0; n < 2; ++n) *(f32x4*)(op + bj * HALF + 16 * n) = acc[ai][bj][m][n] * rs * gv[bj][n]; }
    }
};

template <class Epi, class Sched, bool ALIGN_EPI = false, bool SP2 = false>
__device__ __forceinline__ void gemm_phase(PG8_LAS unsigned char* lds, const Gemm g, const Sched& S, const Epi& E, const int wid) {
    const int lane = fresh_lane(), tid = wid * 64 + lane, wr = wid >> 2, wc = wid & 3, fr = lane & 15, fq = lane >> 4;
    int nt = g.K / BK; asm volatile("" : "+s"(nt));
    unsigned voffA[2], voffB[2];
#pragma unroll
    for (int i = 0; i < 2; ++i) { int R, C; stage_rc(tid * 16 + i * 8192, R, C); const int Rb = Epi::PERM ? ((R & ~31) + perm32(R & 31)) : R;
        voffA[i] = (unsigned)(R * g.lda + C) * 2u; voffB[i] = (unsigned)(Rb * g.ldb + C) * 2u; }
    const size_t kstep = (size_t)(BK * 2);
    const size_t hstepA = (size_t)HALF * g.lda * 2, hstepB = (size_t)HALF * g.ldb * 2;
    const size_t tstepA = 2 * hstepA, tstepB = 2 * hstepB;
    const unsigned ldsw = (unsigned)wid * 1024u;
    const int aoff = lds_byte(wr * 64 + fr, fq * 8), boff = lds_byte(wc * 32 + fr, fq * 8);
#define PG8_SA(b, h) (((b) * 2 + (h)) * HTB)
#define PG8_SB(b, h) ((4 + (b) * 2 + (h)) * HTB)
#define PG8_STAGE(bufoff, gbase, voff) do { _Pragma("unroll") for (int _i = 0; _i < 2; ++_i) \
        __builtin_amdgcn_global_load_lds((const unsigned*)((const char*)(gbase) + (voff)[_i]), (PG8_LAS unsigned*)(lds + (bufoff) + ldsw + _i * 8192), 16, 0, 0); } while (0)
#define PG8_LDA(dst, b, h) do { _Pragma("unroll") for (int m = 0; m < 4; ++m) _Pragma("unroll") for (int k = 0; k < 2; ++k) dst[m][k] = *(const PG8_LAS bf16x8*)(lds + PG8_SA(b, h) + aoff + m * 2048 + k * 1024); } while (0)
#define PG8_LDB(dst, b, h) do { _Pragma("unroll") for (int n = 0; n < 2; ++n) _Pragma("unroll") for (int k = 0; k < 2; ++k) dst[n][k] = *(const PG8_LAS bf16x8*)(lds + PG8_SB(b, h) + boff + n * 2048 + k * 1024); } while (0)
#define PG8_MMA(ai, bj, At, Bt) do { __builtin_amdgcn_s_setprio(1); _Pragma("unroll") for (int m = 0; m < 4; ++m) _Pragma("unroll") for (int n = 0; n < 2; ++n) _Pragma("unroll") for (int k = 0; k < 2; ++k) \
        acc[ai][bj][m][n] = __builtin_amdgcn_mfma_f32_16x16x32_bf16(Bt[n][k], At[m][k], acc[ai][bj][m][n], 0, 0, 0); __builtin_amdgcn_s_setprio(0); } while (0)
#define PG8_WAIT_V(n) asm volatile("s_waitcnt vmcnt(" #n ")" ::: "memory")
#define PG8_WAIT_L(n) asm volatile("s_waitcnt lgkmcnt(" #n ")" ::: "memory")
#define PG8_BAR __builtin_amdgcn_s_barrier()
#define PG8_SCHED __builtin_amdgcn_sched_barrier(0)
    Unit cur, nxt; int ui = 0;
    if (!S.next(0, cur)) return;
    f32x4 acc[2][2][4][2];
    if constexpr (Epi::ACC_INIT) E.init(acc, cur, wr, wc, fr, fq);
    else {
#pragma unroll
    for (int a = 0; a < 2; ++a)
#pragma unroll
        for (int b = 0; b < 2; ++b)
#pragma unroll
            for (int m = 0; m < 4; ++m)
#pragma unroll
                for (int n = 0; n < 2; ++n) acc[a][b][m][n] = (f32x4){0.f, 0.f, 0.f, 0.f};
    }
    bf16x8 At[4][2], B0[2][2], B1[2][2];
    const char* cA = cur.pn >= g.swap_pn ? (const char*)g.A2 + (size_t)(cur.pn - g.swap_pn) * tstepA : (const char*)g.A + (size_t)cur.pm * tstepA + (g.bd ? (size_t)(cur.pn >> 1) * 512 : 0);
    const char* cB = cur.pn >= g.swap_pn ? (const char*)g.B2 + (size_t)cur.pm * tstepB : (const char*)g.Bt + (size_t)cur.pn * tstepB;
    S.a_ready(cur);
    if constexpr (SP2) {
        PG8_STAGE(PG8_SB(0, 0), cB, voffB); PG8_STAGE(PG8_SB(0, 1), cB + hstepB, voffB); PG8_STAGE(PG8_SA(0, 0), cA, voffA); PG8_STAGE(PG8_SA(0, 1), cA + hstepA, voffA);
        if (wr == 1) PG8_BAR;
        PG8_WAIT_V(2); PG8_BAR;
        PG8_STAGE(PG8_SB(1, 0), cB + kstep, voffB); PG8_STAGE(PG8_SA(1, 0), cA + kstep, voffA); PG8_STAGE(PG8_SB(1, 1), cB + hstepB + kstep, voffB);
        PG8_WAIT_V(6); PG8_BAR;
    } else {
        PG8_STAGE(PG8_SB(0, 0), cB, voffB); PG8_STAGE(PG8_SA(0, 0), cA, voffA); PG8_STAGE(PG8_SB(0, 1), cB + hstepB, voffB); PG8_STAGE(PG8_SA(0, 1), cA + hstepA, voffA);
        if (wr == 1) PG8_BAR;
        PG8_WAIT_V(4); PG8_BAR;
        PG8_STAGE(PG8_SB(1, 0), cB + kstep, voffB); PG8_STAGE(PG8_SA(1, 0), cA + kstep, voffA); PG8_STAGE(PG8_SB(1, 1), cB + hstepB + kstep, voffB);
        PG8_WAIT_V(6); PG8_BAR;
    }
    for (;;) {
        const bool has_next = S.next(ui + 1, nxt);
        const char* nA = !has_next ? cA : nxt.pn >= g.swap_pn ? (const char*)g.A2 + (size_t)(nxt.pn - g.swap_pn) * tstepA : (const char*)g.A + (size_t)nxt.pm * tstepA + (g.bd ? (size_t)(nxt.pn >> 1) * 512 : 0);
        const char* nB = !has_next ? cB : nxt.pn >= g.swap_pn ? (const char*)g.B2 + (size_t)nxt.pm * tstepB : (const char*)g.Bt + (size_t)nxt.pn * tstepB;
        for (int t = 0; t < nt; t += 2) {
            const bool last = (t == nt - 2);
            const char* a1 = cA + (size_t)(t + 1) * kstep;
            const char* a2 = last ? nA : cA + (size_t)(t + 2) * kstep; const char* b2 = last ? nB : cB + (size_t)(t + 2) * kstep;
            const char* a3 = a2 + kstep; const char* b3 = b2 + kstep;
            if (last && has_next) S.a_ready(nxt);
            if constexpr (SP2) {
            PG8_LDB(B0, 0, 0); PG8_LDB(B1, 0, 1); PG8_SCHED; PG8_LDA(At, 0, 0); PG8_STAGE(PG8_SA(1, 1), a1 + hstepA, voffA);
            PG8_WAIT_V(8); PG8_WAIT_L(0); PG8_BAR; PG8_MMA(0, 0, At, B0); PG8_MMA(0, 1, At, B1); PG8_BAR; PG8_SCHED;
            PG8_LDA(At, 0, 1); PG8_STAGE(PG8_SB(0, 0), b2, voffB); PG8_STAGE(PG8_SB(0, 1), b2 + hstepB, voffB); PG8_STAGE(PG8_SA(0, 0), a2, voffA);
            PG8_WAIT_V(8); PG8_WAIT_L(0); PG8_BAR; PG8_MMA(1, 0, At, B0); PG8_MMA(1, 1, At, B1); PG8_BAR; PG8_SCHED;
            PG8_LDB(B0, 1, 0); PG8_LDB(B1, 1, 1); PG8_SCHED; PG8_LDA(At, 1, 0); PG8_STAGE(PG8_SA(0, 1), a2 + hstepA, voffA);
            PG8_WAIT_V(8); PG8_WAIT_L(0); PG8_BAR; PG8_MMA(0, 0, At, B0); PG8_MMA(0, 1, At, B1); PG8_BAR; PG8_SCHED;
            PG8_LDA(At, 1, 1); PG8_STAGE(PG8_SB(1, 0), b3, voffB); PG8_STAGE(PG8_SB(1, 1), b3 + hstepB, voffB); PG8_STAGE(PG8_SA(1, 0), a3, voffA);
            PG8_WAIT_V(8); PG8_WAIT_L(0); PG8_BAR; PG8_MMA(1, 0, At, B0); PG8_MMA(1, 1, At, B1); PG8_BAR; PG8_SCHED;
            } else {
            PG8_LDB(B0, 0, 0); PG8_SCHED; PG8_LDA(At, 0, 0); PG8_STAGE(PG8_SA(1, 1), a1 + hstepA, voffA);
            PG8_WAIT_L(8); PG8_BAR; PG8_WAIT_L(0); PG8_MMA(0, 0, At, B0); PG8_BAR; PG8_SCHED;
            PG8_LDB(B1, 0, 1); PG8_STAGE(PG8_SB(0, 0), b2, voffB);
            PG8_BAR; PG8_WAIT_L(0); PG8_MMA(0, 1, At, B1); PG8_BAR;
            PG8_LDA(At, 0, 1); PG8_STAGE(PG8_SA(0, 0), a2, voffA);
            PG8_BAR; PG8_WAIT_L(0); PG8_MMA(1, 0, At, B0); PG8_BAR; PG8_SCHED;
            PG8_STAGE(PG8_SB(0, 1), b2 + hstepB, voffB);
            PG8_WAIT_V(6); PG8_BAR; PG8_MMA(1, 1, At, B1); PG8_BAR;
            PG8_LDB(B0, 1, 0); PG8_SCHED; PG8_LDA(At, 1, 0); PG8_STAGE(PG8_SA(0, 1), a2 + hstepA, voffA);
            PG8_WAIT_L(8); PG8_BAR; PG8_WAIT_L(0); PG8_MMA(0, 0, At, B0); PG8_BAR; PG8_SCHED;
            PG8_LDB(B1, 1, 1); PG8_STAGE(PG8_SB(1, 0), b3, voffB);
            PG8_BAR; PG8_WAIT_L(0); PG8_MMA(0, 1, At, B1); PG8_BAR;
            PG8_LDA(At, 1, 1); PG8_STAGE(PG8_SA(1, 0), a3, voffA);
            PG8_BAR; PG8_WAIT_L(0); PG8_MMA(1, 0, At, B0); PG8_BAR; PG8_SCHED;
            PG8_STAGE(PG8_SB(1, 1), b3 + hstepB, voffB);
            PG8_WAIT_V(6); PG8_BAR; PG8_MMA(1, 1, At, B1); PG8_BAR;
            }
        }
        if constexpr (ALIGN_EPI) { if (wr == 0) PG8_BAR; }
        if constexpr (!Epi::AFTER_DRAIN) { E(acc, cur, wr, wc, fr, fq); S.done(cur); }
        if (!has_next) break;
#pragma unroll
        for (int a = 0; a < 2; ++a)
#pragma unroll
            for (int b = 0; b < 2; ++b)
#pragma unroll
                for (int m = 0; m < 4; ++m)
#pragma unroll
                    for (int n = 0; n < 2; ++n) acc[a][b][m][n] = (f32x4){0.f, 0.f, 0.f, 0.f};
        cur = nxt; cA = nA; cB = nB; ++ui;
        if constexpr (ALIGN_EPI) { if (wr == 1) PG8_BAR; }
    }
    PG8_WAIT_V(0);
    if constexpr (!ALIGN_EPI) { if (wr == 0) PG8_BAR; }
    PG8_BAR;
    if constexpr (Epi::AFTER_DRAIN) { E.fused(acc, cur, wr, wc, fr, fq, lds, wid, lane); S.done(cur); }
#undef PG8_SA
#undef PG8_SB
#undef PG8_STAGE
#undef PG8_LDA
#undef PG8_LDB
#undef PG8_MMA
#undef PG8_WAIT_V
#undef PG8_WAIT_L
#undef PG8_BAR
#undef PG8_SCHED
}
}

constexpr size_t MiB = 1u << 20;
constexpr size_t WS_CTL = 0, WS_PCNT = 16384, CTL_BYTES = 32768;
constexpr size_t WS_WIN = 1 * MiB;
constexpr size_t WS_WG = 5 * MiB;
constexpr size_t WS_WOUT = 6 * MiB;
constexpr size_t WS_WQKV = 8 * MiB;
constexpr size_t WS_WBO = 14 * MiB;
constexpr size_t WS_WGU0 = 16 * MiB, WS_WGU1 = 27 * MiB;
constexpr size_t WS_WD0 = 38 * MiB, WS_WD1 = WS_WD0 + (size_t)DM * DFF * 2;
constexpr size_t WS_SS = 49 * MiB;
constexpr size_t WS_AGGP = 50 * MiB, WS_AGGH = 52 * MiB, WS_CARRY = 54 * MiB;
constexpr size_t WS_C8 = 57 * MiB;
constexpr size_t WS_XB = 58 * MiB;
constexpr size_t WS_R0 = 90 * MiB;
constexpr size_t WS_R1 = 122 * MiB;
constexpr size_t WS_R2 = 154 * MiB;
constexpr size_t WS_R3 = 186 * MiB;
constexpr size_t WS_END = 250 * MiB;
static_assert(WS_WD1 + (size_t)DM * DFF * 2 <= WS_SS && WS_R0 + (size_t)MTOK * DFF * 2 <= WS_R3 && WS_R3 + (size_t)MTOK * DM * 4 <= WS_END, "d_ws map");

constexpr int NWAVES = 8, NTHREADS = NWAVES * 64;
constexpr int LDS_BYTES = 147456;
constexpr int SCAN_L = 32, SCAN_NC = SEQ / SCAN_L;

__device__ __forceinline__ void transpose_item(const float* W, int K, int N, bf16_t* WT, int mode, int rowoff, const float* g, LAS float* scr, int item, int lane) {
    const int nblk = N / 32, kb = item / nblk, nb = item % nblk, k0 = 64 * kb, n0 = 32 * nb;
    const int drow0 = rowoff + (mode ? 256 * (n0 >> 7) + (n0 & 127) : n0);
    float tv[32];
    const float* wp = W + (size_t)(k0 + (lane >> 5)) * N + n0 + (lane & 31);
#pragma unroll
    for (int i = 0; i < 32; ++i) tv[i] = wp[(size_t)(2 * i) * N];
    if (g) {
#pragma unroll
        for (int i = 0; i < 32; ++i) tv[i] *= g[k0 + 2 * i + (lane >> 5)]; }
#pragma unroll
    for (int i = 0; i < 32; ++i) scr[(2 * i + (lane >> 5)) * 33 + (lane & 31)] = tv[i];
    asm volatile("s_waitcnt lgkmcnt(0)" ::: "memory");
    const int c = lane & 7;
#pragma unroll
    for (int j = 0; j < 4; ++j) { const int n = (lane >> 3) + 8 * j; const LAS float* s = scr + (8 * c) * 33 + n;
        u32x4 o; o.x = pk_bf16(s[0 * 33], s[1 * 33]); o.y = pk_bf16(s[2 * 33], s[3 * 33]); o.z = pk_bf16(s[4 * 33], s[5 * 33]); o.w = pk_bf16(s[6 * 33], s[7 * 33]);
        *(u32x4*)(WT + (size_t)(drow0 + n) * K + k0 + 8 * c) = o; }
    asm volatile("s_waitcnt lgkmcnt(0)" ::: "memory");
}

struct Params { const float* in[18]; float* out; unsigned char* ws; };

template <int SET>
__device__ __forceinline__ void convert_weights(const Params& p, LAS unsigned char* lds, int gw, int ngw, int wave, int lane) {
    LAS float* scr = (LAS float*)(lds + wave * 16384);
    unsigned char* ws = p.ws;
    constexpr int I_IN = 16 * 64, I_G = 256, I_SQ = 16 * 32, I_QKV = 16 * 96, I_FF = 16 * 88, I_DN = 44 * 32;
    if constexpr (SET == 0) {
        constexpr int NITEMS = I_IN + I_G + I_SQ + 2 * I_FF;
        for (int it = gw; it < NITEMS; it += ngw) {
            int r = it;
            if (r < I_IN) { transpose_item(p.in[3], DM, 2048, (bf16_t*)(ws + WS_WIN), 0, 0, p.in[1], scr, r, lane); continue; } r -= I_IN;
            if (r < I_G) { const int mtx = r >> 5, blk = mtx & 3, isI = mtx >> 2;
                transpose_item((isI ? p.in[8] : p.in[6]) + blk * 65536, 256, 256, (bf16_t*)(ws + WS_WG), 1, 512 * blk + 128 * isI, nullptr, scr, r & 31, lane); continue; } r -= I_G;
            if (r < I_SQ) { transpose_item(p.in[11], DM, DM, (bf16_t*)(ws + WS_WOUT), 0, 0, nullptr, scr, r, lane); continue; } r -= I_SQ;
            { const int isUp = r / I_FF;
                transpose_item(isUp ? p.in[15] : p.in[14], DM, DFF, (bf16_t*)(ws + WS_WGU0), 1, 128 * isUp, p.in[2], scr, r % I_FF, lane); }
        }
    } else if constexpr (SET == 1) {
        constexpr int NITEMS = I_DN + I_QKV + I_SQ + 2 * I_FF;
        for (int it = gw; it < NITEMS; it += ngw) {
            int r = it;
            if (r < I_DN) { transpose_item(p.in[16], DFF, DM, (bf16_t*)(ws + WS_WD0), 0, 0, nullptr, scr, r, lane); continue; } r -= I_DN;
            if (r < I_QKV) { transpose_item(p.in[12], DM, 3072, (bf16_t*)(ws + WS_WQKV), 0, 0, p.in[1] + DM, scr, r, lane); continue; } r -= I_QKV;
            if (r < I_SQ) { transpose_item(p.in[13], DM, DM, (bf16_t*)(ws + WS_WBO), 0, 0, nullptr, scr, r, lane); continue; } r -= I_SQ;
            { const int isUp = r / I_FF;
                transpose_item((isUp ? p.in[15] : p.in[14]) + (size_t)DM * DFF, DM, DFF, (bf16_t*)(ws + WS_WGU1), 1, 128 * isUp, p.in[2] + DM, scr, r % I_FF, lane); }
        }
    } else {
        for (int it = gw; it < I_DN; it += ngw) transpose_item(p.in[16] + (size_t)DM * DFF, DFF, DM, (bf16_t*)(ws + WS_WD1), 0, 0, nullptr, scr, it, lane);
    }
}
__device__ __forceinline__ void prologue(const Params& p, LAS unsigned char* lds, int gw, int ngw, int wave, int lane) {
    unsigned char* ws = p.ws;
    convert_weights<0>(p, lds, gw, ngw, wave, lane);
    if (gw == 0) { float* c8t = (float*)(ws + WS_C8);
        for (int i = lane; i < DM; i += 64) { const float l = p.in[10][i]; c8t[i] = -8.0f * (fmaxf(-l, 0.f) + log1pf(expf(-fabsf(l)))); } }
    const float* x = p.in[0]; bf16_t* xb = (bf16_t*)(ws + WS_XB); float* ssp = (float*)(ws + WS_SS);
    for (int m = 2 * gw; m < MTOK; m += 2 * ngw) {
        const f32x4* xr = (const f32x4*)(x + (size_t)m * DM) + lane; u32x2* o8 = (u32x2*)(xb + (size_t)m * DM) + lane;
        f32x4 v[8]; float s0 = 0.f, s1 = 0.f;
#pragma unroll
        for (int j = 0; j < 8; ++j) v[j] = xr[64 * j];
#pragma unroll
        for (int j = 0; j < 4; ++j) { s0 += (v[j].x * v[j].x + v[j].y * v[j].y) + (v[j].z * v[j].z + v[j].w * v[j].w); s1 += (v[4 + j].x * v[4 + j].x + v[4 + j].y * v[4 + j].y) + (v[4 + j].z * v[4 + j].z + v[4 + j].w * v[4 + j].w); }
        s0 = wave_sum(s0); s1 = wave_sum(s1);
#pragma unroll
        for (int j = 0; j < 8; ++j) { u32x2 w; w.x = pk_bf16(v[j].x, v[j].y); w.y = pk_bf16(v[j].z, v[j].w); o8[64 * j] = w; }
        if (lane < 8) ssp[(size_t)m * 4 + lane] = lane == 0 ? s0 : (lane == 4 ? s1 : 0.f);
    }
}

__device__ __forceinline__ void conv_phase(const bf16_t* xbr, const float* cw, const float* cb, bf16_t* xc, int gt, int ngt) {
    constexpr int TCH = 16, NIT = BATCH * (SEQ / TCH) * (DM / 8);
    for (int item = gt; item < NIT; item += ngt) {
        const int c8 = item & 127, tc = item >> 7, b = tc / (SEQ / TCH), t0 = (tc % (SEQ / TCH)) * TCH, ch = 8 * c8;
        float w[4][8], bias[8], xm[3][8];
#pragma unroll
        for (int j = 0; j < 4; ++j) { const f32x4 a = *(const f32x4*)(cw + j * DM + ch), c = *(const f32x4*)(cw + j * DM + ch + 4);
            w[j][0] = a[0]; w[j][1] = a[1]; w[j][2] = a[2]; w[j][3] = a[3]; w[j][4] = c[0]; w[j][5] = c[1]; w[j][6] = c[2]; w[j][7] = c[3]; }
        { const f32x4 a = *(const f32x4*)(cb + ch), c = *(const f32x4*)(cb + ch + 4); bias[0] = a[0]; bias[1] = a[1]; bias[2] = a[2]; bias[3] = a[3]; bias[4] = c[0]; bias[5] = c[1]; bias[6] = c[2]; bias[7] = c[3]; }
        const bf16_t* src = xbr + (size_t)(b * SEQ + t0) * DM + ch; bf16_t* dst = xc + (size_t)(b * SEQ + t0) * DM + ch;
#pragma unroll
        for (int j = 0; j < 3; ++j) {
            u32x4 xw = {0u, 0u, 0u, 0u}; if (t0 > 0) xw = *(const u32x4*)(src - (3 - j) * DM);
            xm[j][0] = bf_lo(xw.x); xm[j][1] = bf_hi(xw.x); xm[j][2] = bf_lo(xw.y); xm[j][3] = bf_hi(xw.y); xm[j][4] = bf_lo(xw.z); xm[j][5] = bf_hi(xw.z); xm[j][6] = bf_lo(xw.w); xm[j][7] = bf_hi(xw.w); }
#pragma unroll 8
        for (int t = 0; t < TCH; ++t) {
            const u32x4 xw = *(const u32x4*)(src + (size_t)t * DM);
            float cur[8] = {bf_lo(xw.x), bf_hi(xw.x), bf_lo(xw.y), bf_hi(xw.y), bf_lo(xw.z), bf_hi(xw.z), bf_lo(xw.w), bf_hi(xw.w)};
            float o[8];
#pragma unroll
            for (int e = 0; e < 8; ++e) { o[e] = bias[e] + w[0][e] * xm[0][e] + w[1][e] * xm[1][e] + w[2][e] * xm[2][e] + w[3][e] * cur[e]; xm[0][e] = xm[1][e]; xm[1][e] = xm[2][e]; xm[2][e] = cur[e]; }
            u32x4 ow; ow.x = pk_bf16(o[0], o[1]); ow.y = pk_bf16(o[2], o[3]); ow.z = pk_bf16(o[4], o[5]); ow.w = pk_bf16(o[6], o[7]);
            *(u32x4*)(dst + (size_t)t * DM) = ow;
        }
    }
}

__device__ __forceinline__ void au_unpack(const u32x4 w, f32x4& a, f32x4& u) {
#pragma unroll
    for (int e = 0; e < 4; ++e) { const f32x2 t = unpk_f16(w[e]); a[e] = __builtin_amdgcn_exp2f(t[0] * (1.0f / 1024.0f)); u[e] = t[1]; }
}
constexpr int SCAN_SC = 8, SCAN_NSC = SCAN_NC / SCAN_SC;
__device__ __forceinline__ void scan_pass1_units(const unsigned* au, f32x4* saggP, f32x4* saggH, f32x4* cpreP, f32x4* cpreH, LAS unsigned char* lds, const pg8::StaticOrder& S, int tid) {
    LAS f32x4* sP = (LAS f32x4*)lds; LAS f32x4* sH = sP + 2 * SCAN_SC * 32;
    const int ti = tid >> 8, cl = (tid >> 5) & 7, ql = tid & 31;
    for (int i0 = 0;; i0 += 2) {
        pg8::Unit u; const bool any = S.next(i0, u); if (!any) break;
        const bool mine = S.next(i0 + ti, u);
        const int pm = u.pm, c4 = ((u.pn >> 1) * 256 + (u.pn & 1) * 128) / 4 + ql, ck = pm * SCAN_SC + cl;
        f32x4 P = {1.f, 1.f, 1.f, 1.f}, Hh = {0.f, 0.f, 0.f, 0.f};
        if (mine) { const size_t off = (size_t)ck * SCAN_L * DM + 4 * c4;
#pragma unroll 16
            for (int t = 0; t < SCAN_L; ++t) { f32x4 a, uu; au_unpack(*(const u32x4*)(au + off + (size_t)t * DM), a, uu); Hh = a * Hh + uu; P = P * a; } }
        sP[(ti * SCAN_SC + cl) * 32 + ql] = P; sH[(ti * SCAN_SC + cl) * 32 + ql] = Hh;
        asm volatile("s_waitcnt lgkmcnt(0)" ::: "memory"); __syncthreads();
        f32x4 pP = {1.f, 1.f, 1.f, 1.f}, pH = {0.f, 0.f, 0.f, 0.f};
        for (int j = 0; j < cl; ++j) { const f32x4 p = sP[(ti * SCAN_SC + j) * 32 + ql], h = sH[(ti * SCAN_SC + j) * 32 + ql]; pH = p * pH + h; pP = pP * p; }
        if (mine) { cpreP[(size_t)ck * 256 + c4] = pP; cpreH[(size_t)ck * 256 + c4] = pH;
            if (cl == SCAN_SC - 1) { saggP[(size_t)pm * 256 + c4] = pP * P; saggH[(size_t)pm * 256 + c4] = P * pH + Hh; } }
        asm volatile("s_waitcnt lgkmcnt(0)" ::: "memory"); __syncthreads();
    }
}
__device__ __forceinline__ void scan_pass2_tile(const unsigned* au, const f32x4* saggP, const f32x4* saggH, const f32x4* cpreP, const f32x4* cpreH, const bf16_t* gate, bf16_t* y, int pm, int blk, int tid) {
    const int cl = tid >> 6, ql = tid & 63, b = pm / SCAN_NSC, c4 = blk * 64 + ql, ck = pm * SCAN_SC + cl;
    f32x4 C = {0.f, 0.f, 0.f, 0.f};
    for (int j = b * SCAN_NSC; j < pm; ++j) { const f32x4 p = saggP[(size_t)j * 256 + c4], h = saggH[(size_t)j * 256 + c4]; C = p * C + h; }
    f32x4 Hh = cpreP[(size_t)ck * 256 + c4] * C + cpreH[(size_t)ck * 256 + c4];
    const size_t off = (size_t)ck * SCAN_L * DM + 4 * c4;
#pragma unroll 16
    for (int t = 0; t < SCAN_L; ++t) { const size_t o = off + (size_t)t * DM; f32x4 a, u; au_unpack(*(const u32x4*)(au + o), a, u); const u32x2 gw2 = *(const u32x2*)(gate + o);
        Hh = a * Hh + u;
        u32x2 w; w.x = pk_bf16(Hh[0] * bf_lo(gw2.x), Hh[1] * bf_hi(gw2.x)); w.y = pk_bf16(Hh[2] * bf_lo(gw2.y), Hh[3] * bf_hi(gw2.y));
        *(u32x2*)(y + o) = w; }
}
__device__ __forceinline__ int crow16(int i, int h) { return (i & 3) + 8 * (i >> 2) + 4 * h; }
#define ATT_LOAD(KF, VF, kbi) do { const bf16_t* kp_ = kfrag + (size_t)(kbi) * 2048; const bf16_t* vp_ = vfrag + (size_t)(kbi) * 2048; \
    _Pragma("unroll") for (int s_ = 0; s_ < 4; ++s_) { KF[s_] = *(const bf16x8*)(kp_ + s_ * 512); VF[s_] = *(const bf16x8*)(vp_ + s_ * 512); } } while (0)
#define ATT_STEP(KF, VF, DIAG) do { \
    f32x16 pz; _Pragma("unroll") for (int i_ = 0; i_ < 16; ++i_) pz[i_] = 0.f; \
    _Pragma("unroll") for (int s_ = 0; s_ < 4; ++s_) pz = __builtin_amdgcn_mfma_f32_32x32x16_bf16(KF[s_], qf[s_], pz, 0, 0, 0); \
    float beta[16], f[16]; \
    _Pragma("unroll") for (int i_ = 0; i_ < 16; ++i_) { \
        const float bt_ = __builtin_amdgcn_rcpf(1.0f + __builtin_amdgcn_exp2f(-pz[i_]));     \
        const bool dead_ = (DIAG) && (crow16(i_, h) >= r);                                   \
        beta[i_] = dead_ ? 0.f : bt_; f[i_] = 1.0f - beta[i_]; } \
    float w[16]; float accp = R; \
    _Pragma("unroll") for (int g_ = 3; g_ >= 0; --g_) { \
        const float G_ = (f[4 * g_] * f[4 * g_ + 1]) * (f[4 * g_ + 2] * f[4 * g_ + 3]); \
        const auto rr_ = __builtin_amdgcn_permlane32_swap(__float_as_uint(G_), __float_as_uint(G_), false, false); \
        const float glo_ = __uint_as_float(rr_[0]), ghi_ = __uint_as_float(rr_[1]);          \
        float E_ = h ? accp : accp * ghi_; \
        accp = accp * (glo_ * ghi_); \
        w[4 * g_ + 3] = beta[4 * g_ + 3] * E_; E_ *= f[4 * g_ + 3]; \
        w[4 * g_ + 2] = beta[4 * g_ + 2] * E_; E_ *= f[4 * g_ + 2]; \
        w[4 * g_ + 1] = beta[4 * g_ + 1] * E_; E_ *= f[4 * g_ + 1]; \
        w[4 * g_] = beta[4 * g_] * E_; } \
    R = accp; \
    _Pragma("unroll") for (int s_ = 0; s_ < 2; ++s_) { \
        u32x4 t_; t_.x = pk_bf16(w[8 * s_], w[8 * s_ + 1]); t_.y = pk_bf16(w[8 * s_ + 2], w[8 * s_ + 3]); t_.z = pk_bf16(w[8 * s_ + 4], w[8 * s_ + 5]); t_.w = pk_bf16(w[8 * s_ + 6], w[8 * s_ + 7]); \
        const bf16x8 pw_ = __builtin_bit_cast(bf16x8, t_); \
        o0 = __builtin_amdgcn_mfma_f32_32x32x16_bf16(VF[s_], pw_, o0, 0, 0, 0); \
        o1 = __builtin_amdgcn_mfma_f32_32x32x16_bf16(VF[2 + s_], pw_, o1, 0, 0, 0); } } while (0)
__device__ __forceinline__ void attn_phase(const bf16_t* Q, const bf16_t* K, const bf16_t* VT, bf16_t* O, int gw, int ngw, int lane) {
    const int r = lane & 31, h = lane >> 5;
    constexpr int NQB = SEQ / 32;
    for (int unit = gw; unit < BATCH * NHEAD * NQB; unit += ngw) {
        const int bh = unit / NQB, qb = unit % NQB, b = bh / NHEAD, hd = bh % NHEAD;
        const bf16_t* qp = Q + ((size_t)(bh * NQB + qb) * 256 + lane) * 8;
        bf16x8 qf[4];
#pragma unroll
        for (int s = 0; s < 4; ++s) qf[s] = *(const bf16x8*)(qp + s * 512);
        const bf16_t* kfrag = K + ((size_t)bh * NQB * 256 + lane) * 8;
        const bf16_t* vfrag = VT + ((size_t)bh * NQB * 256 + lane) * 8;
        f32x16 o0, o1;
#pragma unroll
        for (int i = 0; i < 16; ++i) { o0[i] = 0.f; o1[i] = 0.f; }
        float R = 1.0f;
        bf16x8 kA[4], vA[4], kB[4], vB[4];
        ATT_LOAD(kA, vA, qb);
        for (int kb = qb;;) {
            ATT_LOAD(kB, vB, kb > 0 ? kb - 1 : 0);
            ATT_STEP(kA, vA, kb == qb);
            if (kb == 0 || !__any(R >= 1.17549435e-38f)) break;
            --kb;
            ATT_LOAD(kA, vA, kb > 0 ? kb - 1 : 0);
            ATT_STEP(kB, vB, false);
            if (kb == 0 || !__any(R >= 1.17549435e-38f)) break;
            --kb;
        }
        bf16_t* op = O + (size_t)(b * SEQ + qb * 32 + r) * DM + hd * HDIM + 4 * h;
#pragma unroll
        for (int g = 0; g < 4; ++g) {
            u32x2 w0; w0.x = pk_bf16(o0[4 * g], o0[4 * g + 1]); w0.y = pk_bf16(o0[4 * g + 2], o0[4 * g + 3]);
            u32x2 w1; w1.x = pk_bf16(o1[4 * g], o1[4 * g + 1]); w1.y = pk_bf16(o1[4 * g + 2], o1[4 * g + 3]);
            *(u32x2*)(op + 8 * g) = w0; *(u32x2*)(op + 32 + 8 * g) = w1;
        }
    }
}
#undef ATT_LOAD
#undef ATT_STEP

__device__ __forceinline__ void final_norm(float* x, const float* ssp, const float* g, int gw, int ngw, int lane) {
    f32x4 gv[4];
#pragma unroll
    for (int j = 0; j < 4; ++j) gv[j] = *((const f32x4*)g + lane + 64 * j);
    for (int m = gw; m < MTOK; m += ngw) {
        const float rs = row_rs(ssp, m);
        f32x4* xr = (f32x4*)(x + (size_t)m * DM) + lane;
#pragma unroll
        for (int j = 0; j < 4; ++j) xr[64 * j] = xr[64 * j] * rs * gv[j];
    }
}


#define XB_TMO      128
#define XB_XCNT(j)  (256  + 64 * (j))
#define XB_XSUB(j)  (1280 + 64 * (j))
#define XB_XGEN(j)  (2304 + 64 * (j))
#define XB_TOP      3328
#define XB_TOPGEN   3392
#define XCD_BAR_WORDS 3456
#define XB_SPIN_CAP (1u << 22)
__device__ __forceinline__ unsigned xb_ld(unsigned* p)              { return __hip_atomic_load(p, __ATOMIC_RELAXED, __HIP_MEMORY_SCOPE_AGENT); }
__device__ __forceinline__ unsigned xb_add(unsigned* p, unsigned v) { return __hip_atomic_fetch_add(p, v, __ATOMIC_RELAXED, __HIP_MEMORY_SCOPE_AGENT); }
__device__ __forceinline__ unsigned xb_xcc_id() { return (unsigned)__builtin_amdgcn_s_getreg((3 << 11) | 20) & 0xFu; }
#define XB_SPIN(cond, bar) do { unsigned _sp = 0; while (cond) { __builtin_amdgcn_s_sleep(1); \
    if ((++_sp & 255u) == 0u) { if (xb_ld(&(bar)[XB_TMO])) break; if (_sp > XB_SPIN_CAP) { atomicAdd(&(bar)[XB_TMO], 1u); break; } } } } while (0)
struct XcdBarrier { unsigned* bar; unsigned x; volatile LAS unsigned* st; };
__device__ __forceinline__ XcdBarrier xcd_barrier_post(unsigned* bar, volatile LAS unsigned* st, bool leader) {
    XcdBarrier b; b.bar = bar; b.x = xb_xcc_id(); b.st = st;
    if (leader) (void)xb_add(&bar[XB_XCNT(b.x)], 1u);
    return b;
}
__device__ __forceinline__ void xcd_barrier_complete(unsigned* bar, unsigned x, unsigned& nloc, unsigned& nx) {
    const unsigned G = gridDim.x * gridDim.y * gridDim.z;
    unsigned sum, cnt, mine, sp = 0u;
    for (;;) {
        sum = 0u; cnt = 0u; mine = 0u;
#pragma unroll
        for (unsigned j = 0; j < 16; ++j) { const unsigned c = xb_ld(&bar[XB_XCNT(j)]); sum += c; cnt += (c > 0u) ? 1u : 0u; mine = (j == x) ? c : mine; }
        if (sum == G) break;
        __builtin_amdgcn_s_sleep(1);
        if ((++sp & 255u) == 0u) { if (xb_ld(&bar[XB_TMO])) break; if (sp > XB_SPIN_CAP) { atomicAdd(&bar[XB_TMO], 1u); break; } }
    }
    nloc = mine > 0u ? mine : 1u; nx = cnt > 0u ? cnt : 1u;
}
__device__ __forceinline__ void xcd_barrier(const XcdBarrier& b, bool leader) {
    asm volatile("s_waitcnt vmcnt(0)" ::: "memory");
    __syncthreads();
    if (leader) {
        unsigned* bar = b.bar;
        __builtin_amdgcn_s_waitcnt(0);
        unsigned nloc = b.st[0], nx = b.st[1];
        if (nloc == 0u) { xcd_barrier_complete(bar, b.x, nloc, nx); b.st[0] = nloc; b.st[1] = nx; }
        const unsigned old = xb_add(&bar[XB_XSUB(b.x)], 1u);
        const unsigned gen = old / nloc;
        if (old + 1u == (gen + 1u) * nloc) {
            __builtin_amdgcn_fence(__ATOMIC_RELEASE, "agent");
            asm volatile("s_waitcnt vmcnt(0)" ::: "memory");
            const unsigned og = xb_add(&bar[XB_TOP], 1u);
            const unsigned tg = og / nx;
            if (og + 1u == (tg + 1u) * nx) xb_add(&bar[XB_TOPGEN], 1u);
        }
        XB_SPIN(xb_ld(&bar[XB_TOPGEN]) == gen, bar);
        __builtin_amdgcn_fence(__ATOMIC_ACQUIRE, "agent");
        asm volatile("s_waitcnt vmcnt(0)" ::: "memory");
    }
    __syncthreads();
}

constexpr int RST_OFF = 131072;
__device__ __forceinline__ int fill_rs_table(LAS unsigned char* lds, const float* ssp, const pg8::StaticOrder& S, int tid) {
    pg8::Unit u0; const int row_base = S.next(0, u0) ? (u0.pm / pg8::WGM) * pg8::WGM * pg8::BM : 0;
    LAS float* rst = (LAS float*)(lds + RST_OFF);
    for (int i = tid; i < pg8::WGM * pg8::BM; i += NTHREADS) rst[i] = row_rs(ssp, row_base + i);
    asm volatile("s_waitcnt lgkmcnt(0)" ::: "memory"); __syncthreads();
    return row_base;
}

__global__ void __launch_bounds__(NTHREADS, 2) fwd_megakernel(Params p) {
    extern __shared__ __attribute__((aligned(16))) unsigned char lds_raw[];
    LAS unsigned char* lds = (LAS unsigned char*)lds_raw;
    cg::grid_group grid = cg::this_grid();
    const int wave = __builtin_amdgcn_readfirstlane(threadIdx.x >> 6);
    const int G = gridDim.x, bx = blockIdx.x;
    const int vcu = (G % 8 == 0) ? (bx % 8) * (G / 8) + bx / 8 : bx;
    const int gw = vcu * NWAVES + wave, ngw = G * NWAVES, ngt = G * NTHREADS;
#define GT() (vcu * NTHREADS + wave * 64 + fresh_lane())
    unsigned char* ws = p.ws;
    volatile LAS unsigned* bst = (volatile LAS unsigned*)(lds + LDS_BYTES - 64);
    const bool leader = (wave == 0) && (fresh_lane() == 0);
    if (leader) { bst[0] = 0u; bst[1] = 0u; }
    XcdBarrier xbar = xcd_barrier_post((unsigned*)(ws + WS_CTL), bst, leader);
#define GSYNC() xcd_barrier(xbar, (wave == 0) && (fresh_lane() == 0))
    float* ssp = (float*)(ws + WS_SS);
    bf16_t* XB = (bf16_t*)(ws + WS_XB);
    bf16_t* R0 = (bf16_t*)(ws + WS_R0); bf16_t* R1 = (bf16_t*)(ws + WS_R1); bf16_t* R2 = (bf16_t*)(ws + WS_R2); bf16_t* R3 = (bf16_t*)(ws + WS_R3);
    unsigned* AU = (unsigned*)(ws + WS_R3);

    prologue(p, lds, gw, ngw, wave, fresh_lane());
    if (p.ws == nullptr) grid.sync();
    GSYNC();

    {   pg8::Gemm g{XB, (const bf16_t*)(ws + WS_WIN), MTOK, 2048, DM, DM, DM, 0}; pg8::StaticOrder S; S.init(MTOK, 2048, G, bx);
        const int rb = fill_rs_table(lds, ssp, S, wave * 64 + fresh_lane());
        pg8::EpiInProj E{R0, R1, (const LAS float*)(lds + RST_OFF), rb};
        pg8::gemm_phase<pg8::EpiInProj, pg8::StaticOrder, true, true>(lds, g, S, E, wave); }
    GSYNC();
    conv_phase(R1, p.in[4], p.in[5], R2, GT(), ngt);
    GSYNC();
    {   pg8::Gemm g{R2, (const bf16_t*)(ws + WS_WG), MTOK, 2048, 256, DM, 256, 1}; pg8::StaticOrder S; S.init(MTOK, 2048, G, bx);
        pg8::EpiGates E{R2, p.in[7], p.in[9], (const float*)(ws + WS_C8), AU};
        pg8::gemm_phase<pg8::EpiGates, pg8::StaticOrder, true, true>(lds, g, S, E, wave);
        asm volatile("s_waitcnt vmcnt(0)" ::: "memory"); __syncthreads();
        scan_pass1_units(AU, (f32x4*)(ws + WS_AGGP), (f32x4*)(ws + WS_AGGP + 512 * 1024), (f32x4*)(ws + WS_AGGH), (f32x4*)(ws + WS_CARRY), lds, S, wave * 64 + fresh_lane()); }
    GSYNC();
    for (int wi = bx; wi < (MTOK / 256) * 4; wi += G)
        scan_pass2_tile(AU, (const f32x4*)(ws + WS_AGGP), (const f32x4*)(ws + WS_AGGP + 512 * 1024), (const f32x4*)(ws + WS_AGGH), (const f32x4*)(ws + WS_CARRY), R0, R1, wi >> 2, wi & 3, wave * 64 + fresh_lane());
    GSYNC();
    {   pg8::Gemm g{R1, (const bf16_t*)(ws + WS_WOUT), MTOK, DM, DM, DM, DM, 0}; pg8::StaticOrder S; S.init(MTOK, DM, G, bx);
        pg8::EpiResid E{XB, ssp};
        pg8::gemm_phase<pg8::EpiResid, pg8::StaticOrder, false, true>(lds, g, S, E, wave); }
    GSYNC();
#pragma unroll
    for (int layer = 0; layer < 2; ++layer) {
        {   pg8::Gemm g{XB, (const bf16_t*)(ws + (layer ? WS_WGU1 : WS_WGU0)), MTOK, 2 * DFF, DM, DM, DM, 0}; pg8::StaticOrder S; S.init(MTOK, 2 * DFF, G, bx);
            const int rb = fill_rs_table(lds, ssp, S, wave * 64 + fresh_lane());
            pg8::EpiSwiglu E{R0, (const LAS float*)(lds + RST_OFF), rb};
            pg8::gemm_phase<pg8::EpiSwiglu, pg8::StaticOrder, true, true>(lds, g, S, E, wave);
            {   pg8::Unit ul; const int rounds = (S.nwg + G - 1) / G;
                if (S.nwg % G != 0 && !S.next(rounds - 1, ul)) { const int nidle = G - S.nwg % G, rank = bx - S.nwg % G;
                    if (layer == 0) convert_weights<1>(p, lds, rank * NWAVES + wave, nidle * NWAVES, wave, fresh_lane());
                    else convert_weights<2>(p, lds, rank * NWAVES + wave, nidle * NWAVES, wave, fresh_lane()); } } }
        GSYNC();
        {   pg8::Gemm g{R0, (const bf16_t*)(ws + (layer ? WS_WD1 : WS_WD0)), MTOK, DM, DFF, DFF, DFF, 0}; pg8::StaticOrder S; S.init(MTOK, DM, G, bx);
            if (layer == 0) { pg8::EpiResid E{XB, ssp}; pg8::gemm_phase<pg8::EpiResid, pg8::StaticOrder, false, true>(lds, g, S, E, wave); }
            else { pg8::EpiFinal E{XB, ssp, (unsigned*)(ws + WS_PCNT), p.in[17], p.out}; pg8::gemm_phase<pg8::EpiFinal, pg8::StaticOrder, false, true>(lds, g, S, E, wave); } }
        if (layer == 0) {
            GSYNC();
            {   pg8::Gemm g{XB, (const bf16_t*)(ws + WS_WQKV), MTOK, 3072, DM, DM, DM, 0, (const bf16_t*)(ws + WS_WQKV) + (size_t)2048 * DM, XB, 8}; pg8::StaticOrder S; S.init(MTOK, 3072, G, bx);
                const int rb = fill_rs_table(lds, ssp, S, wave * 64 + fresh_lane());
                pg8::EpiQKV E{pg8::EpiQK{R0, R1, (const LAS float*)(lds + RST_OFF), rb, 0.125f * LOG2E}, pg8::EpiVT{R2, (const LAS float*)(lds + RST_OFF), rb}};
                pg8::gemm_phase<pg8::EpiQKV, pg8::StaticOrder, true, true>(lds, g, S, E, wave); }
            GSYNC();
            attn_phase(R0, R1, R2, R3, gw, ngw, fresh_lane());
            GSYNC();
            {   pg8::Gemm g{R3, (const bf16_t*)(ws + WS_WBO), MTOK, DM, DM, DM, DM, 0}; pg8::StaticOrder S; S.init(MTOK, DM, G, bx);
                pg8::EpiResid E{XB, ssp};
                pg8::gemm_phase<pg8::EpiResid, pg8::StaticOrder, false, true>(lds, g, S, E, wave); }
            GSYNC();
        }
    }
}

extern "C" void kernel_launch(void* const* d_in, const int* in_sizes, int n_in, void* d_out, int out_size, void* d_ws, size_t ws_size, hipStream_t stream) {
    static int grid = 0;
    if (grid == 0) {
        if (n_in != 18 || out_size != MTOK * DM || ws_size < WS_END) { fprintf(stderr, "kernel_launch: unexpected shapes (n_in %d, out %d, ws %zu)\n", n_in, out_size, ws_size); grid = -1; return; }
        int dev = 0, cus = 0, per_cu = 0;
        (void)hipGetDevice(&dev); (void)hipDeviceGetAttribute(&cus, hipDeviceAttributeMultiprocessorCount, dev);
        if (hipFuncSetAttribute((const void*)fwd_megakernel, hipFuncAttributeMaxDynamicSharedMemorySize, LDS_BYTES) != hipSuccess) { fprintf(stderr, "kernel_launch: hipFuncSetAttribute failed\n"); grid = -1; return; }
        if (hipOccupancyMaxActiveBlocksPerMultiprocessor(&per_cu, (const void*)fwd_megakernel, NTHREADS, LDS_BYTES) != hipSuccess || per_cu < 1) { fprintf(stderr, "kernel_launch: occupancy query says %d blocks per CU\n", per_cu); per_cu = 1; }
        (void)hipGetLastError();
        grid = cus;
        if (grid != 256) fprintf(stderr, "kernel_launch: %d CUs; this kernel is built for 256\n", grid);
    }
    if (grid < 0) return;
    if (hipMemsetAsync((char*)d_ws + WS_CTL, 0, CTL_BYTES, stream) != hipSuccess) { fprintf(stderr, "kernel_launch: hipMemsetAsync failed\n"); return; }
    Params p{};
    for (int i = 0; i < 18; ++i) p.in[i] = (const float*)d_in[i];
    p.out = (float*)d_out; p.ws = (unsigned char*)d_ws;
    void* args[] = {&p};
    const hipError_t e = hipLaunchCooperativeKernel((const void*)fwd_megakernel, dim3(grid), dim3(NTHREADS), args, LDS_BYTES, stream);
    if (e != hipSuccess) fprintf(stderr, "kernel_launch: cooperative launch failed: %s (grid %d)\n", hipGetErrorString(e), grid);
}
```

```cpp
#include <hip/hip_runtime.h>
#include <hip/hip_cooperative_groups.h>
#include <cstdio>
#include <cstdint>
namespace cg = cooperative_groups;

#define LAS __attribute__((address_space(3)))
typedef unsigned short bf16_t;
typedef short bf16x8 __attribute__((ext_vector_type(8)));
typedef short s16x4 __attribute__((ext_vector_type(4)));
typedef float f32x2 __attribute__((ext_vector_type(2)));
typedef float f32x4 __attribute__((ext_vector_type(4)));
typedef float f32x16 __attribute__((ext_vector_type(16)));
typedef unsigned u32x2 __attribute__((ext_vector_type(2)));
typedef unsigned u32x4 __attribute__((ext_vector_type(4)));
typedef __bf16 bf16v2 __attribute__((ext_vector_type(2)));

constexpr int BATCH = 2, SEQ = 8192, DM = 1024, MTOK = BATCH * SEQ, DFF = 2816, NHEAD = 16, HDIM = 64;
constexpr float RMS_EPS = 1e-6f;
constexpr float LOG2E = 1.4426950408889634f;

__device__ __forceinline__ unsigned pk_bf16(float lo, float hi) { f32x2 v = {lo, hi}; return __builtin_bit_cast(unsigned, __builtin_convertvector(v, bf16v2)); }
typedef _Float16 f16v2 __attribute__((ext_vector_type(2)));
__device__ __forceinline__ unsigned pk_f16(float lo, float hi) { f32x2 v = {lo, hi}; return __builtin_bit_cast(unsigned, __builtin_convertvector(v, f16v2)); }
__device__ __forceinline__ f32x2 unpk_f16(unsigned w) { return __builtin_convertvector(__builtin_bit_cast(f16v2, w), f32x2); }
__device__ __forceinline__ float bf_lo(unsigned w) { return __uint_as_float(w << 16); }
__device__ __forceinline__ float bf_hi(unsigned w) { return __uint_as_float(w & 0xffff0000u); }
__device__ __forceinline__ float fast_sigmoid(float v) { return __builtin_amdgcn_rcpf(1.0f + __builtin_amdgcn_exp2f(-v * LOG2E)); }
__device__ __forceinline__ float gelu_tanh(float x) { const float y2 = x * (1.5957691216057308f + 0.07135481627f * x * x); return x * __builtin_amdgcn_rcpf(1.0f + __builtin_amdgcn_exp2f(-y2 * LOG2E)); }
__device__ __forceinline__ int fresh_lane() { int l; asm volatile("v_mbcnt_lo_u32_b32 %0, -1, 0\n\tv_mbcnt_hi_u32_b32 %0, -1, %0" : "=v"(l)); return l; }
__device__ __forceinline__ float wave_sum(float v) {
#pragma unroll
    for (int o = 1; o < 64; o <<= 1) v += __shfl_xor(v, o);
    return v;
}
__device__ __forceinline__ float row_rs(const float* ssp, int row) { const f32x4 s = *(const f32x4*)(ssp + (size_t)row * 4); return rsqrtf(((s[0] + s[1]) + (s[2] + s[3])) * (1.0f / DM) + RMS_EPS); }

namespace pg8 {
#define PG8_LAS __attribute__((address_space(3)))
constexpr int BM = 256, BK = 64, HALF = 128, HTB = HALF * BK * 2  , STAGE_BYTES = 8 * HTB, NXCD = 8, WGM = 8;

__host__ __device__ __forceinline__ int lds_byte(int r, int c) { const int st = (r >> 4) * 2 + (c >> 5), rr = r & 15, cc = c & 31, ob = rr * 64 + cc * 2; return st * 1024 + (ob ^ (((ob >> 9) & 1) << 5)); }
__host__ __device__ __forceinline__ void stage_rc(int b, int& R, int& C) { const int st = b / 1024, sb = b % 1024, swz = sb ^ (((sb >> 9) & 1) << 5); R = (st >> 1) * 16 + swz / 64; C = (st & 1) * 32 + (swz % 64) / 2; }
__host__ __device__ __forceinline__ int perm32(int rho) { const int n = rho >> 4, i = rho & 15; return 8 * (i >> 2) + 4 * n + (i & 3); }

struct Unit { int pm, pn; };
struct Gemm { const bf16_t* A; const bf16_t* Bt; int M, N, K, lda, ldb, bd; const bf16_t* A2 = nullptr; const bf16_t* B2 = nullptr; int swap_pn = 1 << 30; };

struct StaticOrder {
    int nM, nN, nwg, G, c;
    __host__ __device__ void init(int M, int N, int G_, int c_) { nM = M / BM; nN = N / BM; nwg = nM * nN; G = G_; c = c_; }
    __host__ __device__ bool next(int i, Unit& u) const {
        const long L = (long)i * G + c; if (L >= nwg) return false;
        int wgid = (int)L; { const int q = nwg / NXCD, r = nwg % NXCD, xcd = wgid % NXCD, off = wgid / NXCD; wgid = (xcd < r ? xcd * (q + 1) : r * (q + 1) + (xcd - r) * q) + off; }
        const int nig = WGM * nN, gid = wgid / nig, fm = gid * WGM, gsz = (nM - fm) < WGM ? (nM - fm) : WGM;
        u.pm = fm + ((wgid % nig) % gsz); u.pn = (wgid % nig) / gsz; return true;
    }
    __device__ __forceinline__ void a_ready(const Unit&) const {}
    __device__ __forceinline__ void done(const Unit&) const {}
};

typedef f32x4 AccT[2][2][4][2];

struct EpiInProj {
    static constexpr bool PERM = true, AFTER_DRAIN = false, ACC_INIT = false;
    bf16_t* gate; bf16_t* xbr; const LAS float* rst; int row_base;
    __device__ __forceinline__ void operator()(const AccT& acc, const Unit& u, int wr, int wc, int fr, int fq) const {
        const bool isgate = u.pn < 4;
        bf16_t* base = isgate ? gate : xbr;
        const int row0 = u.pm * BM + wr * 64 + fr, col0 = (u.pn & 3) * BM + wc * 32 + 8 * fq;
#pragma unroll
        for (int ai = 0; ai < 2; ++ai)
#pragma unroll
            for (int m = 0; m < 4; ++m) { const int row = row0 + ai * HALF + m * 16; const float rs = rst[row - row_base]; bf16_t* rowp = base + (size_t)row * DM + col0;
#pragma unroll
                for (int bj = 0; bj < 2; ++bj) { f32x4 v0 = acc[ai][bj][m][0] * rs, v1 = acc[ai][bj][m][1] * rs;
                    if (isgate) {
#pragma unroll
                        for (int e = 0; e < 4; ++e) { v0[e] = gelu_tanh(v0[e]); v1[e] = gelu_tanh(v1[e]); } }
                    u32x4 w; w.x = pk_bf16(v0[0], v0[1]); w.y = pk_bf16(v0[2], v0[3]); w.z = pk_bf16(v1[0], v1[1]); w.w = pk_bf16(v1[2], v1[3]);
                    *(u32x4*)(rowp + bj * HALF) = w; } }
    }
};

struct EpiGates {
    static constexpr bool PERM = true, AFTER_DRAIN = false, ACC_INIT = false;
    const bf16_t* xc; const float* b_r; const float* b_i; const float* c8t; unsigned* au_out;
    __device__ __forceinline__ void operator()(const AccT& acc, const Unit& u, int wr, int wc, int fr, int fq) const {
        const int ch0 = (u.pn >> 1) * 256 + (u.pn & 1) * 128 + wc * 32 + 8 * fq, row0 = u.pm * BM + wr * 64 + fr;
        f32x4 br[2], bi[2], c8[2];
#pragma unroll
        for (int n = 0; n < 2; ++n) { br[n] = *(const f32x4*)(b_r + ch0 + 4 * n); bi[n] = *(const f32x4*)(b_i + ch0 + 4 * n); c8[n] = *(const f32x4*)(c8t + ch0 + 4 * n); }
#pragma unroll
        for (int ai = 0; ai < 2; ++ai)
#pragma unroll
            for (int m = 0; m < 4; ++m) { const unsigned off = (unsigned)(row0 + ai * HALF + m * 16) * DM + ch0;
                const u32x4 xw = *(const u32x4*)(xc + off);
                const float xv[8] = {bf_lo(xw.x), bf_hi(xw.x), bf_lo(xw.y), bf_hi(xw.y), bf_lo(xw.z), bf_hi(xw.z), bf_lo(xw.w), bf_hi(xw.w)};
                u32x4 pk[2];
#pragma unroll
                for (int n = 0; n < 2; ++n)
#pragma unroll
                    for (int e = 0; e < 4; ++e) {
                        const float rr = fast_sigmoid(acc[ai][0][m][n][e] + br[n][e]), ii = fast_sigmoid(acc[ai][1][m][n][e] + bi[n][e]);
                        const float la = c8[n][e] * rr, a = __builtin_amdgcn_exp2f(la * LOG2E), x2 = 2.0f * la;
                        const float ser = -x2 * (1.0f + x2 * (0.5f + x2 * (0.16666667f + x2 * 0.041666668f)));
                        const float m2 = x2 > -0.06f ? ser : 1.0f - a * a;
                        pk[n][e] = pk_f16(la * (LOG2E * 1024.0f), __builtin_amdgcn_sqrtf(fmaxf(m2, 0.f)) * (ii * xv[4 * n + e])); }
                *(u32x4*)(au_out + off) = pk[0]; *(u32x4*)(au_out + off + 4) = pk[1];
                asm volatile("" ::: "memory"); }
    }
};

struct EpiSwiglu {
    static constexpr bool PERM = true, AFTER_DRAIN = false, ACC_INIT = false;
    bf16_t* hid; const LAS float* rst; int row_base;
    __device__ __forceinline__ void operator()(const AccT& acc, const Unit& u, int wr, int wc, int fr, int fq) const {
        const int row0 = u.pm * BM + wr * 64 + fr, col0 = u.pn * HALF + wc * 32 + 8 * fq;
#pragma unroll
        for (int ai = 0; ai < 2; ++ai)
#pragma unroll
            for (int m = 0; m < 4; ++m) { const int row = row0 + ai * HALF + m * 16; const float rs = rst[row - row_base];
                float hv[8];
#pragma unroll
                for (int n = 0; n < 2; ++n)
#pragma unroll
                    for (int e = 0; e < 4; ++e) { const float g = acc[ai][0][m][n][e] * rs, uu = acc[ai][1][m][n][e] * rs; hv[4 * n + e] = g * fast_sigmoid(g) * uu; }
                u32x4 w; w.x = pk_bf16(hv[0], hv[1]); w.y = pk_bf16(hv[2], hv[3]); w.z = pk_bf16(hv[4], hv[5]); w.w = pk_bf16(hv[6], hv[7]);
                *(u32x4*)(hid + (size_t)row * DFF + col0) = w; }
    }
};

struct EpiQK {
    static constexpr bool PERM = true, AFTER_DRAIN = false, ACC_INIT = false;
    bf16_t* q; bf16_t* k; const LAS float* rst; int row_base; float qscale;
    __device__ __forceinline__ void operator()(const AccT& acc, const Unit& u, int wr, int wc, int fr, int fq) const {
        const bool isq = u.pn < 4; bf16_t* base = isq ? q : k; const float sc = isq ? qscale : 1.0f;
        const int row0 = u.pm * BM + wr * 64 + fr, col0 = (u.pn & 3) * BM + wc * 32 + 8 * fq;
#pragma unroll
        for (int ai = 0; ai < 2; ++ai)
#pragma unroll
            for (int m = 0; m < 4; ++m) { const int row = row0 + ai * HALF + m * 16; const float rs = rst[row - row_base] * sc;
                const unsigned b = (unsigned)row >> 13, t = (unsigned)row & 8191u;
#pragma unroll
                for (int bj = 0; bj < 2; ++bj) { const f32x4 v0 = acc[ai][bj][m][0] * rs, v1 = acc[ai][bj][m][1] * rs;
                    const unsigned col = col0 + bj * HALF, hd = col >> 6, d0 = col & 63u;
                    const unsigned off = ((((b * NHEAD + hd) * 256u + (t >> 5)) * 4u + (d0 >> 4)) * 64u + ((d0 >> 3) & 1u) * 32u + (t & 31u)) * 8u;
                    u32x4 w; w.x = pk_bf16(v0[0], v0[1]); w.y = pk_bf16(v0[2], v0[3]); w.z = pk_bf16(v1[0], v1[1]); w.w = pk_bf16(v1[2], v1[3]);
                    *(u32x4*)(base + off) = w; } }
    }
};

struct EpiVT {
    static constexpr bool PERM = true, AFTER_DRAIN = false, ACC_INIT = false;
    bf16_t* vt; const LAS float* rst; int row_base;
    __device__ __forceinline__ void operator()(const AccT& acc, const Unit& u, int wr, int wc, int fr, int fq) const {
        const int row0 = u.pm * BM + wr * 64 + fr, tok0 = u.pn * BM + wc * 32 + 8 * fq;
        float rsv[2][8];
#pragma unroll
        for (int bj = 0; bj < 2; ++bj)
#pragma unroll
            for (int j = 0; j < 8; ++j) rsv[bj][j] = rst[tok0 + bj * HALF + j - row_base];
#pragma unroll
        for (int ai = 0; ai < 2; ++ai)
#pragma unroll
            for (int m = 0; m < 4; ++m) { const unsigned row = row0 + ai * HALF + m * 16, hd = row >> 6, d = row & 63u;
#pragma unroll
                for (int bj = 0; bj < 2; ++bj) { const f32x4 a0 = acc[ai][bj][m][0], a1 = acc[ai][bj][m][1];
                    const unsigned tok = tok0 + bj * HALF, b = tok >> 13, t = tok & 8191u;
                    const unsigned off = (((((b * NHEAD + hd) * 256u + (t >> 5)) * 2u + (d >> 5)) * 2u + ((t >> 4) & 1u)) * 64u + (d & 31u)) * 8u + 4u * ((t >> 3) & 1u);
                    u32x2 w0, w1; w0.x = pk_bf16(a0[0] * rsv[bj][0], a0[1] * rsv[bj][1]); w0.y = pk_bf16(a0[2] * rsv[bj][2], a0[3] * rsv[bj][3]);
                    w1.x = pk_bf16(a1[0] * rsv[bj][4], a1[1] * rsv[bj][5]); w1.y = pk_bf16(a1[2] * rsv[bj][6], a1[3] * rsv[bj][7]);
                    *(u32x2*)(vt + off) = w0; *(u32x2*)(vt + off + 32 * 8) = w1; } }
    }
};

struct EpiQKV {
    static constexpr bool PERM = true, AFTER_DRAIN = false, ACC_INIT = false;
    EpiQK qk; EpiVT vt;
    __device__ __forceinline__ void operator()(const AccT& acc, const Unit& u, int wr, int wc, int fr, int fq) const {
        if (u.pn >= 8) { const Unit ut{u.pn - 8, u.pm}; vt(acc, ut, wr, wc, fr, fq); } else qk(acc, u, wr, wc, fr, fq);
    }
};

__device__ __forceinline__ void acc_from_xb(AccT& acc, const bf16_t* xb, const Unit& u, int wr, int wc, int fr, int fq) {
    const unsigned off0 = (unsigned)(u.pm * BM + wr * 64 + fr) * DM + u.pn * BM + wc * 32 + 8 * fq;
#pragma unroll
    for (int ai = 0; ai < 2; ++ai)
#pragma unroll
        for (int m = 0; m < 4; ++m)
#pragma unroll
            for (int bj = 0; bj < 2; ++bj) { const u32x4 w = *(const u32x4*)(xb + off0 + (unsigned)(ai * HALF + m * 16) * DM + bj * HALF);
                acc[ai][bj][m][0] = (f32x4){bf_lo(w.x), bf_hi(w.x), bf_lo(w.y), bf_hi(w.y)}; acc[ai][bj][m][1] = (f32x4){bf_lo(w.z), bf_hi(w.z), bf_lo(w.w), bf_hi(w.w)}; }
}
__device__ __forceinline__ void tile_row_ss(const AccT& acc, PG8_LAS float* P, int wr, int wc, int fr, int fq) {
#pragma unroll
    for (int ai = 0; ai < 2; ++ai)
#pragma unroll
        for (int m = 0; m < 4; ++m) { float ss = 0.f;
#pragma unroll
            for (int bj = 0; bj < 2; ++bj) { const f32x4 v0 = acc[ai][bj][m][0], v1 = acc[ai][bj][m][1];
                ss += (v0[0] * v0[0] + v0[1] * v0[1]) + (v0[2] * v0[2] + v0[3] * v0[3]) + (v1[0] * v1[0] + v1[1] * v1[1]) + (v1[2] * v1[2] + v1[3] * v1[3]); }
            ss += __shfl_xor(ss, 16); ss += __shfl_xor(ss, 32);
            if (fq == 0) P[(ai * HALF + wr * 64 + m * 16 + fr) * 4 + wc] = ss; }
}
struct EpiResid {
    static constexpr bool PERM = true, AFTER_DRAIN = true, ACC_INIT = true;
    bf16_t* xb; float* ssp;
    __device__ __forceinline__ void init(AccT& acc, const Unit& u, int wr, int wc, int fr, int fq) const { acc_from_xb(acc, xb, u, wr, wc, fr, fq); }
    __device__ __forceinline__ void fused(AccT& acc, const Unit& u, int wr, int wc, int fr, int fq, PG8_LAS unsigned char* lds, int wid, int lane) const {
        PG8_LAS float* P = (PG8_LAS float*)lds;
        const unsigned off0 = (unsigned)(u.pm * BM + wr * 64 + fr) * DM + u.pn * BM + wc * 32 + 8 * fq;
#pragma unroll
        for (int ai = 0; ai < 2; ++ai)
#pragma unroll
            for (int m = 0; m < 4; ++m)
#pragma unroll
                for (int bj = 0; bj < 2; ++bj) { const f32x4 v0 = acc[ai][bj][m][0], v1 = acc[ai][bj][m][1];
                    u32x4 w; w.x = pk_bf16(v0[0], v0[1]); w.y = pk_bf16(v0[2], v0[3]); w.z = pk_bf16(v1[0], v1[1]); w.w = pk_bf16(v1[2], v1[3]);
                    *(u32x4*)(xb + off0 + (unsigned)(ai * HALF + m * 16) * DM + bj * HALF) = w; }
        tile_row_ss(acc, P, wr, wc, fr, fq);
        asm volatile("s_waitcnt lgkmcnt(0)" ::: "memory"); __builtin_amdgcn_s_barrier(); asm volatile("" ::: "memory");
        const int tid = wid * 64 + lane;
        if (tid < 256) { const f32x4 p = *(const PG8_LAS f32x4*)(P + tid * 4); ssp[(size_t)(u.pm * BM + tid) * 4 + u.pn] = (p[0] + p[1]) + (p[2] + p[3]); }
    }
};
struct EpiFinal {
    static constexpr bool PERM = true, AFTER_DRAIN = true, ACC_INIT = true;
    const bf16_t* xb; float* ssp; unsigned* cnt; const float* g; float* out;
    __device__ __forceinline__ void init(AccT& acc, const Unit& u, int wr, int wc, int fr, int fq) const { acc_from_xb(acc, xb, u, wr, wc, fr, fq); }
    __device__ __forceinline__ void fused(AccT& acc, const Unit& u, int wr, int wc, int fr, int fq, PG8_LAS unsigned char* lds, int wid, int lane) const {
        PG8_LAS float* P = (PG8_LAS float*)lds;
        PG8_LAS float* RS = (PG8_LAS float*)(lds + 4096);
        tile_row_ss(acc, P, wr, wc, fr, fq);
        asm volatile("s_waitcnt lgkmcnt(0)" ::: "memory"); __builtin_amdgcn_s_barrier(); asm volatile("" ::: "memory");
        const int tid = wid * 64 + lane;
        if (tid < 256) { const f32x4 p = *(const PG8_LAS f32x4*)(P + tid * 4);
            __hip_atomic_store(ssp + (size_t)(u.pm * BM + tid) * 4 + u.pn, (p[0] + p[1]) + (p[2] + p[3]), __ATOMIC_RELAXED, __HIP_MEMORY_SCOPE_AGENT); }
        asm volatile("s_waitcnt vmcnt(0)" ::: "memory");
        unsigned* c = cnt + 64 * u.pm;
        if (lane == 0) __hip_atomic_fetch_add(c, 1u, __ATOMIC_RELAXED, __HIP_MEMORY_SCOPE_AGENT);
        if (wid == 0) {
            unsigned sp = 0;
            while ((unsigned)__builtin_amdgcn_readfirstlane(__hip_atomic_load(c, __ATOMIC_RELAXED, __HIP_MEMORY_SCOPE_AGENT)) < 32u) { __builtin_amdgcn_s_sleep(2); if (++sp > (1u << 24)) break; }
            __builtin_amdgcn_fence(__ATOMIC_ACQUIRE, "agent");
        }
        asm volatile("s_waitcnt vmcnt(0) lgkmcnt(0)" ::: "memory"); __builtin_amdgcn_s_barrier(); asm volatile("" ::: "memory");
        if (tid < 256) { const float* sl = ssp + (size_t)(u.pm * BM + tid) * 4; float s = 0.f;
#pragma unroll
            for (int t = 0; t < 4; ++t) s += __hip_atomic_load(sl + t, __ATOMIC_RELAXED, __HIP_MEMORY_SCOPE_AGENT);
            RS[tid] = rsqrtf(s * (1.0f / DM) + RMS_EPS); }
        asm volatile("s_waitcnt vmcnt(0) lgkmcnt(0)" ::: "memory"); __builtin_amdgcn_s_barrier(); asm volatile("" ::: "memory");
        const int col0 = u.pn * BM + wc * 32 + 8 * fq;
        f32x4 gv[2][2];
#pragma unroll
        for (int bj = 0; bj < 2; ++bj) { gv[bj][0] = *(const f32x4*)(g + col0 + bj * HALF); gv[bj][1] = *(const f32x4*)(g + col0 + bj * HALF + 4); }
#pragma unroll
        for (int ai = 0; ai < 2; ++ai)
#pragma unroll
            for (int m = 0; m < 4; ++m) { const int rl = ai * HALF + wr * 64 + m * 16 + fr; const float rs = RS[rl]; float* op = out + (size_t)(u.pm * BM + rl) * DM + col0;
#pragma unroll
                for (int bj = 0; bj < 2; ++bj) { *(f32x4*)(op + bj * HALF) = acc[ai][bj][m][0] * rs * gv[bj][0]; *(f32x4*)(op + bj * HALF + 4) = acc[ai][bj][m][1] * rs * gv[bj][1]; } }
    }
};

template <class Epi, class Sched, bool ALIGN_EPI = false, bool SP2 = false>
__device__ __forceinline__ void gemm_phase(PG8_LAS unsigned char* lds, const Gemm g, const Sched& S, const Epi& E, const int wid) {
    const int lane = fresh_lane(), tid = wid * 64 + lane, wr = wid >> 2, wc = wid & 3, fr = lane & 15, fq = lane >> 4;
    int nt = g.K / BK; asm volatile("" : "+s"(nt));
    unsigned voffA[2], voffB[2];
#pragma unroll
    for (int i = 0; i < 2; ++i) { int R, C; stage_rc(tid * 16 + i * 8192, R, C); const int Rb = Epi::PERM ? ((R & ~31) + perm32(R & 31)) : R;
        voffA[i] = (unsigned)(R * g.lda + C) * 2u; voffB[i] = (unsigned)(Rb * g.ldb + C) * 2u; }
    const size_t kstep = (size_t)(BK * 2);
    const size_t hstepA = (size_t)HALF * g.lda * 2, hstepB = (size_t)HALF * g.ldb * 2;
    const size_t tstepA = 2 * hstepA, tstepB = 2 * hstepB;
    const unsigned ldsw = (unsigned)wid * 1024u;
    const int aoff = lds_byte(wr * 64 + fr, fq * 8), boff = lds_byte(wc * 32 + fr, fq * 8);
#define PG8_SA(b, h) (((b) * 2 + (h)) * HTB)
#define PG8_SB(b, h) ((4 + (b) * 2 + (h)) * HTB)
#define PG8_STAGE(bufoff, gbase, voff) do { _Pragma("unroll") for (int _i = 0; _i < 2; ++_i) \
        __builtin_amdgcn_global_load_lds((const unsigned*)((const char*)(gbase) + (voff)[_i]), (PG8_LAS unsigned*)(lds + (bufoff) + ldsw + _i * 8192), 16, 0, 0); } while (0)
#define PG8_LDA(dst, b, h) do { _Pragma("unroll") for (int m = 0; m < 4; ++m) _Pragma("unroll") for (int k = 0; k < 2; ++k) dst[m][k] = *(const PG8_LAS bf16x8*)(lds + PG8_SA(b, h) + aoff + m * 2048 + k * 1024); } while (0)
#define PG8_LDB(dst, b, h) do { _Pragma("unroll") for (int n = 0; n < 2; ++n) _Pragma("unroll") for (int k = 0; k < 2; ++k) dst[n][k] = *(const PG8_LAS bf16x8*)(lds + PG8_SB(b, h) + boff + n * 2048 + k * 1024); } while (0)
#define PG8_MMA(ai, bj, At, Bt) do { __builtin_amdgcn_s_setprio(1); _Pragma("unroll") for (int m = 0; m < 4; ++m) _Pragma("unroll") for (int n = 0; n < 2; ++n) _Pragma("unroll") for (int k = 0; k < 2; ++k) \
        acc[ai][bj][m][n] = __builtin_amdgcn_mfma_f32_16x16x32_bf16(Bt[n][k], At[m][k], acc[ai][bj][m][n], 0, 0, 0); __builtin_amdgcn_s_setprio(0); } while (0)
#define PG8_WAIT_V(n) asm volatile("s_waitcnt vmcnt(" #n ")" ::: "memory")
#define PG8_WAIT_L(n) asm volatile("s_waitcnt lgkmcnt(" #n ")" ::: "memory")
#define PG8_BAR __builtin_amdgcn_s_barrier()
#define PG8_SCHED __builtin_amdgcn_sched_barrier(0)
    Unit cur, nxt; int ui = 0;
    if (!S.next(0, cur)) return;
    f32x4 acc[2][2][4][2];
    if constexpr (Epi::ACC_INIT) E.init(acc, cur, wr, wc, fr, fq);
    else {
#pragma unroll
    for (int a = 0; a < 2; ++a)
#pragma unroll
        for (int b = 0; b < 2; ++b)
#pragma unroll
            for (int m = 0; m < 4; ++m)
#pragma unroll
                for (int n = 0; n < 2; ++n) acc[a][b][m][n] = (f32x4){0.f, 0.f, 0.f, 0.f};
    }
    bf16x8 At[4][2], B0[2][2], B1[2][2];
    const char* cA = cur.pn >= g.swap_pn ? (const char*)g.A2 + (size_t)(cur.pn - g.swap_pn) * tstepA : (const char*)g.A + (size_t)cur.pm * tstepA + (g.bd ? (size_t)(cur.pn >> 1) * 512 : 0);
    const char* cB = cur.pn >= g.swap_pn ? (const char*)g.B2 + (size_t)cur.pm * tstepB : (const char*)g.Bt + (size_t)cur.pn * tstepB;
    S.a_ready(cur);
    if constexpr (SP2) {
        PG8_STAGE(PG8_SB(0, 0), cB, voffB); PG8_STAGE(PG8_SB(0, 1), cB + hstepB, voffB); PG8_STAGE(PG8_SA(0, 0), cA, voffA); PG8_STAGE(PG8_SA(0, 1), cA + hstepA, voffA);
        if (wr == 1) PG8_BAR;
        PG8_WAIT_V(2); PG8_BAR;
        PG8_STAGE(PG8_SB(1, 0), cB + kstep, voffB); PG8_STAGE(PG8_SA(1, 0), cA + kstep, voffA); PG8_STAGE(PG8_SB(1, 1), cB + hstepB + kstep, voffB);
        PG8_WAIT_V(6); PG8_BAR;
    } else {
        PG8_STAGE(PG8_SB(0, 0), cB, voffB); PG8_STAGE(PG8_SA(0, 0), cA, voffA); PG8_STAGE(PG8_SB(0, 1), cB + hstepB, voffB); PG8_STAGE(PG8_SA(0, 1), cA + hstepA, voffA);
        if (wr == 1) PG8_BAR;
        PG8_WAIT_V(4); PG8_BAR;
        PG8_STAGE(PG8_SB(1, 0), cB + kstep, voffB); PG8_STAGE(PG8_SA(1, 0), cA + kstep, voffA); PG8_STAGE(PG8_SB(1, 1), cB + hstepB + kstep, voffB);
        PG8_WAIT_V(6); PG8_BAR;
    }
    for (;;) {
        const bool has_next = S.next(ui + 1, nxt);
        const char* nA = !has_next ? cA : nxt.pn >= g.swap_pn ? (const char*)g.A2 + (size_t)(nxt.pn - g.swap_pn) * tstepA : (const char*)g.A + (size_t)nxt.pm * tstepA + (g.bd ? (size_t)(nxt.pn >> 1) * 512 : 0);
        const char* nB = !has_next ? cB : nxt.pn >= g.swap_pn ? (const char*)g.B2 + (size_t)nxt.pm * tstepB : (const char*)g.Bt + (size_t)nxt.pn * tstepB;
        for (int t = 0; t < nt; t += 2) {
            const bool last = (t == nt - 2);
            const char* a1 = cA + (size_t)(t + 1) * kstep;
            const char* a2 = last ? nA : cA + (size_t)(t + 2) * kstep; const char* b2 = last ? nB : cB + (size_t)(t + 2) * kstep;
            const char* a3 = a2 + kstep; const char* b3 = b2 + kstep;
            if (last && has_next) S.a_ready(nxt);
            if constexpr (SP2) {
            PG8_LDB(B0, 0, 0); PG8_LDB(B1, 0, 1); PG8_SCHED; PG8_LDA(At, 0, 0); PG8_STAGE(PG8_SA(1, 1), a1 + hstepA, voffA);
            PG8_WAIT_V(8); PG8_WAIT_L(0); PG8_BAR; PG8_MMA(0, 0, At, B0); PG8_MMA(0, 1, At, B1); PG8_BAR; PG8_SCHED;
            PG8_LDA(At, 0, 1); PG8_STAGE(PG8_SB(0, 0), b2, voffB); PG8_STAGE(PG8_SB(0, 1), b2 + hstepB, voffB); PG8_STAGE(PG8_SA(0, 0), a2, voffA);
            PG8_WAIT_V(8); PG8_WAIT_L(0); PG8_BAR; PG8_MMA(1, 0, At, B0); PG8_MMA(1, 1, At, B1); PG8_BAR; PG8_SCHED;
            PG8_LDB(B0, 1, 0); PG8_LDB(B1, 1, 1); PG8_SCHED; PG8_LDA(At, 1, 0); PG8_STAGE(PG8_SA(0, 1), a2 + hstepA, voffA);
            PG8_WAIT_V(8); PG8_WAIT_L(0); PG8_BAR; PG8_MMA(0, 0, At, B0); PG8_MMA(0, 1, At, B1); PG8_BAR; PG8_SCHED;
            PG8_LDA(At, 1, 1); PG8_STAGE(PG8_SB(1, 0), b3, voffB); PG8_STAGE(PG8_SB(1, 1), b3 + hstepB, voffB); PG8_STAGE(PG8_SA(1, 0), a3, voffA);
            PG8_WAIT_V(8); PG8_WAIT_L(0); PG8_BAR; PG8_MMA(1, 0, At, B0); PG8_MMA(1, 1, At, B1); PG8_BAR; PG8_SCHED;
            } else {
            PG8_LDB(B0, 0, 0); PG8_SCHED; PG8_LDA(At, 0, 0); PG8_STAGE(PG8_SA(1, 1), a1 + hstepA, voffA);
            PG8_WAIT_L(8); PG8_BAR; PG8_WAIT_L(0); PG8_MMA(0, 0, At, B0); PG8_BAR; PG8_SCHED;
            PG8_LDB(B1, 0, 1); PG8_STAGE(PG8_SB(0, 0), b2, voffB);
            PG8_BAR; PG8_WAIT_L(0); PG8_MMA(0, 1, At, B1); PG8_BAR;
            PG8_LDA(At, 0, 1); PG8_STAGE(PG8_SA(0, 0), a2, voffA);
            PG8_BAR; PG8_WAIT_L(0); PG8_MMA(1, 0, At, B0); PG8_BAR; PG8_SCHED;
            PG8_STAGE(PG8_SB(0, 1), b2 + hstepB, voffB);
            PG8_WAIT_V(6); PG8_BAR; PG8_MMA(1, 1, At, B1); PG8_BAR;
            PG8_LDB(B0, 1, 0); PG8_SCHED; PG8_LDA(At, 1, 0); PG8_STAGE(PG8_SA(0, 1), a2 + hstepA, voffA);
            PG8_WAIT_L(8); PG8_BAR; PG8_WAIT_L(0); PG8_MMA(0, 0, At, B0); PG8_BAR; PG8_SCHED;
            PG8_LDB(B1, 1, 1); PG8_STAGE(PG8_SB(1, 0), b3, voffB);
            PG8_BAR; PG8_WAIT_L(0); PG8_MMA(0, 1, At, B1); PG8_BAR;
            PG8_LDA(At, 1, 1); PG8_STAGE(PG8_SA(1, 0), a3, voffA);
            PG8_BAR; PG8_WAIT_L(0); PG8_MMA(1, 0, At, B0); PG8_BAR; PG8_SCHED;
            PG8_STAGE(PG8_SB(1, 1), b3 + hstepB, voffB);
            PG8_WAIT_V(6); PG8_BAR; PG8_MMA(1, 1, At, B1); PG8_BAR;
            }
        }
        if constexpr (ALIGN_EPI) { if (wr == 0) PG8_BAR; }
        if constexpr (!Epi::AFTER_DRAIN) { E(acc, cur, wr, wc, fr, fq); S.done(cur); }
        if (!has_next) break;
#pragma unroll
        for (int a = 0; a < 2; ++a)
#pragma unroll
            for (int b = 0; b < 2; ++b)
#pragma unroll
                for (int m = 0; m < 4; ++m)
#pragma unroll
                    for (int n = 0; n < 2; ++n) acc[a][b][m][n] = (f32x4){0.f, 0.f, 0.f, 0.f};
        cur = nxt; cA = nA; cB = nB; ++ui;
        if constexpr (ALIGN_EPI) { if (wr == 1) PG8_BAR; }
    }
    PG8_WAIT_V(0);
    if constexpr (!ALIGN_EPI) { if (wr == 0) PG8_BAR; }
    PG8_BAR;
    if constexpr (Epi::AFTER_DRAIN) { E.fused(acc, cur, wr, wc, fr, fq, lds, wid, lane); S.done(cur); }
#undef PG8_SA
#undef PG8_SB
#undef PG8_STAGE
#undef PG8_LDA
#undef PG8_LDB
#undef PG8_MMA
#undef PG8_WAIT_V
#undef PG8_WAIT_L
#undef PG8_BAR
#undef PG8_SCHED
}
}

constexpr size_t MiB = 1u << 20;
constexpr size_t WS_CTL = 0, WS_PCNT = 16384, CTL_BYTES = 32768;
constexpr size_t WS_WIN = 1 * MiB;
constexpr size_t WS_WG = 5 * MiB;
constexpr size_t WS_WOUT = 6 * MiB;
constexpr size_t WS_WQKV = 8 * MiB;
constexpr size_t WS_WBO = 14 * MiB;
constexpr size_t WS_WGU0 = 16 * MiB, WS_WGU1 = 27 * MiB;
constexpr size_t WS_WD0 = 38 * MiB, WS_WD1 = WS_WD0 + (size_t)DM * DFF * 2;
constexpr size_t WS_SS = 49 * MiB;
constexpr size_t WS_AGGP = 50 * MiB, WS_AGGH = 52 * MiB, WS_CARRY = 54 * MiB;
constexpr size_t WS_C8 = 57 * MiB;
constexpr size_t WS_XB = 58 * MiB;
constexpr size_t WS_R0 = 90 * MiB;
constexpr size_t WS_R1 = 122 * MiB;
constexpr size_t WS_R2 = 154 * MiB;
constexpr size_t WS_R3 = 186 * MiB;
constexpr size_t WS_END = 250 * MiB;
static_assert(WS_WD1 + (size_t)DM * DFF * 2 <= WS_SS && WS_R0 + (size_t)MTOK * DFF * 2 <= WS_R3 && WS_R3 + (size_t)MTOK * DM * 4 <= WS_END, "d_ws map");

constexpr int NWAVES = 8, NTHREADS = NWAVES * 64;
constexpr int LDS_BYTES = 147456;
constexpr int SCAN_L = 32, SCAN_NC = SEQ / SCAN_L;

__device__ __forceinline__ void transpose_item(const float* W, int K, int N, bf16_t* WT, int mode, int rowoff, const float* g, LAS float* scr, int item, int lane) {
    const int nblk = N / 32, kb = item / nblk, nb = item % nblk, k0 = 64 * kb, n0 = 32 * nb;
    const int drow0 = rowoff + (mode ? 256 * (n0 >> 7) + (n0 & 127) : n0);
    float tv[32];
    const float* wp = W + (size_t)(k0 + (lane >> 5)) * N + n0 + (lane & 31);
#pragma unroll
    for (int i = 0; i < 32; ++i) tv[i] = __builtin_nontemporal_load(wp + (size_t)(2 * i) * N);
    if (g) {
#pragma unroll
        for (int i = 0; i < 32; ++i) tv[i] *= g[k0 + 2 * i + (lane >> 5)]; }
#pragma unroll
    for (int i = 0; i < 32; ++i) scr[(2 * i + (lane >> 5)) * 33 + (lane & 31)] = tv[i];
    asm volatile("s_waitcnt lgkmcnt(0)" ::: "memory");
    const int c = lane & 7;
#pragma unroll
    for (int j = 0; j < 4; ++j) { const int n = (lane >> 3) + 8 * j; const LAS float* s = scr + (8 * c) * 33 + n;
        u32x4 o; o.x = pk_bf16(s[0 * 33], s[1 * 33]); o.y = pk_bf16(s[2 * 33], s[3 * 33]); o.z = pk_bf16(s[4 * 33], s[5 * 33]); o.w = pk_bf16(s[6 * 33], s[7 * 33]);
        *(u32x4*)(WT + (size_t)(drow0 + n) * K + k0 + 8 * c) = o; }
    asm volatile("s_waitcnt lgkmcnt(0)" ::: "memory");
}

struct Params { const float* in[18]; float* out; unsigned char* ws; };

template <int SET>
__device__ __forceinline__ void convert_weights(const Params& p, LAS unsigned char* lds, int gw, int ngw, int wave, int lane) {
    LAS float* scr = (LAS float*)(lds + wave * 16384);
    unsigned char* ws = p.ws;
    constexpr int I_IN = 16 * 64, I_G = 256, I_SQ = 16 * 32, I_QKV = 16 * 96, I_FF = 16 * 88, I_DN = 44 * 32;
    if constexpr (SET == 0) {
        constexpr int NITEMS = I_IN + I_G + I_SQ + 2 * I_FF;
        for (int it = gw; it < NITEMS; it += ngw) {
            int r = it;
            if (r < I_IN) { transpose_item(p.in[3], DM, 2048, (bf16_t*)(ws + WS_WIN), 0, 0, p.in[1], scr, r, lane); continue; } r -= I_IN;
            if (r < I_G) { const int mtx = r >> 5, blk = mtx & 3, isI = mtx >> 2;
                transpose_item((isI ? p.in[8] : p.in[6]) + blk * 65536, 256, 256, (bf16_t*)(ws + WS_WG), 1, 512 * blk + 128 * isI, nullptr, scr, r & 31, lane); continue; } r -= I_G;
            if (r < I_SQ) { transpose_item(p.in[11], DM, DM, (bf16_t*)(ws + WS_WOUT), 0, 0, nullptr, scr, r, lane); continue; } r -= I_SQ;
            { const int isUp = r / I_FF;
                transpose_item(isUp ? p.in[15] : p.in[14], DM, DFF, (bf16_t*)(ws + WS_WGU0), 1, 128 * isUp, p.in[2], scr, r % I_FF, lane); }
        }
    } else if constexpr (SET == 1) {
        constexpr int NITEMS = I_DN + I_QKV + I_SQ + 2 * I_FF;
        for (int it = gw; it < NITEMS; it += ngw) {
            int r = it;
            if (r < I_DN) { transpose_item(p.in[16], DFF, DM, (bf16_t*)(ws + WS_WD0), 0, 0, nullptr, scr, r, lane); continue; } r -= I_DN;
            if (r < I_QKV) { transpose_item(p.in[12], DM, 3072, (bf16_t*)(ws + WS_WQKV), 0, 0, p.in[1] + DM, scr, r, lane); continue; } r -= I_QKV;
            if (r < I_SQ) { transpose_item(p.in[13], DM, DM, (bf16_t*)(ws + WS_WBO), 0, 0, nullptr, scr, r, lane); continue; } r -= I_SQ;
            { const int isUp = r / I_FF;
                transpose_item((isUp ? p.in[15] : p.in[14]) + (size_t)DM * DFF, DM, DFF, (bf16_t*)(ws + WS_WGU1), 1, 128 * isUp, p.in[2] + DM, scr, r % I_FF, lane); }
        }
    } else {
        for (int it = gw; it < I_DN; it += ngw) transpose_item(p.in[16] + (size_t)DM * DFF, DFF, DM, (bf16_t*)(ws + WS_WD1), 0, 0, nullptr, scr, it, lane);
    }
}
__device__ __forceinline__ void prologue(const Params& p, LAS unsigned char* lds, int gw, int ngw, int wave, int lane) {
    unsigned char* ws = p.ws;
    convert_weights<0>(p, lds, gw, ngw, wave, lane);
    if (gw == 0) { float* c8t = (float*)(ws + WS_C8);
        for (int i = lane; i < DM; i += 64) { const float l = p.in[10][i]; c8t[i] = -8.0f * (fmaxf(-l, 0.f) + log1pf(expf(-fabsf(l)))); } }
    const float* x = p.in[0]; bf16_t* xb = (bf16_t*)(ws + WS_XB); float* ssp = (float*)(ws + WS_SS);
    for (int m = 2 * gw; m < MTOK; m += 2 * ngw) {
        const f32x4* xr = (const f32x4*)(x + (size_t)m * DM) + lane; u32x2* o8 = (u32x2*)(xb + (size_t)m * DM) + lane;
        f32x4 v[8]; float s0 = 0.f, s1 = 0.f;
#pragma unroll
        for (int j = 0; j < 8; ++j) v[j] = __builtin_nontemporal_load(xr + 64 * j);
#pragma unroll
        for (int j = 0; j < 4; ++j) { s0 += (v[j].x * v[j].x + v[j].y * v[j].y) + (v[j].z * v[j].z + v[j].w * v[j].w); s1 += (v[4 + j].x * v[4 + j].x + v[4 + j].y * v[4 + j].y) + (v[4 + j].z * v[4 + j].z + v[4 + j].w * v[4 + j].w); }
        s0 = wave_sum(s0); s1 = wave_sum(s1);
#pragma unroll
        for (int j = 0; j < 8; ++j) { u32x2 w; w.x = pk_bf16(v[j].x, v[j].y); w.y = pk_bf16(v[j].z, v[j].w); o8[64 * j] = w; }
        if (lane < 8) ssp[(size_t)m * 4 + lane] = lane == 0 ? s0 : (lane == 4 ? s1 : 0.f);
    }
}

__device__ __forceinline__ void conv_phase(const bf16_t* xbr, const float* cw, const float* cb, bf16_t* xc, int gt, int ngt) {
    constexpr int TCH = 16, NIT = BATCH * (SEQ / TCH) * (DM / 8);
    for (int item = gt; item < NIT; item += ngt) {
        const int c8 = item & 127, tc = item >> 7, b = tc / (SEQ / TCH), t0 = (tc % (SEQ / TCH)) * TCH, ch = 8 * c8;
        float w[4][8], bias[8], xm[3][8];
#pragma unroll
        for (int j = 0; j < 4; ++j) { const f32x4 a = *(const f32x4*)(cw + j * DM + ch), c = *(const f32x4*)(cw + j * DM + ch + 4);
            w[j][0] = a[0]; w[j][1] = a[1]; w[j][2] = a[2]; w[j][3] = a[3]; w[j][4] = c[0]; w[j][5] = c[1]; w[j][6] = c[2]; w[j][7] = c[3]; }
        { const f32x4 a = *(const f32x4*)(cb + ch), c = *(const f32x4*)(cb + ch + 4); bias[0] = a[0]; bias[1] = a[1]; bias[2] = a[2]; bias[3] = a[3]; bias[4] = c[0]; bias[5] = c[1]; bias[6] = c[2]; bias[7] = c[3]; }
        const bf16_t* src = xbr + (size_t)(b * SEQ + t0) * DM + ch; bf16_t* dst = xc + (size_t)(b * SEQ + t0) * DM + ch;
#pragma unroll
        for (int j = 0; j < 3; ++j) {
            u32x4 xw = {0u, 0u, 0u, 0u}; if (t0 > 0) xw = *(const u32x4*)(src - (3 - j) * DM);
            xm[j][0] = bf_lo(xw.x); xm[j][1] = bf_hi(xw.x); xm[j][2] = bf_lo(xw.y); xm[j][3] = bf_hi(xw.y); xm[j][4] = bf_lo(xw.z); xm[j][5] = bf_hi(xw.z); xm[j][6] = bf_lo(xw.w); xm[j][7] = bf_hi(xw.w); }
#pragma unroll 8
        for (int t = 0; t < TCH; ++t) {
            const u32x4 xw = *(const u32x4*)(src + (size_t)t * DM);
            float cur[8] = {bf_lo(xw.x), bf_hi(xw.x), bf_lo(xw.y), bf_hi(xw.y), bf_lo(xw.z), bf_hi(xw.z), bf_lo(xw.w), bf_hi(xw.w)};
            float o[8];
#pragma unroll
            for (int e = 0; e < 8; ++e) { o[e] = bias[e] + w[0][e] * xm[0][e] + w[1][e] * xm[1][e] + w[2][e] * xm[2][e] + w[3][e] * cur[e]; xm[0][e] = xm[1][e]; xm[1][e] = xm[2][e]; xm[2][e] = cur[e]; }
            u32x4 ow; ow.x = pk_bf16(o[0], o[1]); ow.y = pk_bf16(o[2], o[3]); ow.z = pk_bf16(o[4], o[5]); ow.w = pk_bf16(o[6], o[7]);
            *(u32x4*)(dst + (size_t)t * DM) = ow;
        }
    }
}

__device__ __forceinline__ void au_unpack(const u32x4 w, f32x4& a, f32x4& u) {
#pragma unroll
    for (int e = 0; e < 4; ++e) { const f32x2 t = unpk_f16(w[e]); a[e] = __builtin_amdgcn_exp2f(t[0] * (1.0f / 1024.0f)); u[e] = t[1]; }
}
constexpr int SCAN_SC = 8, SCAN_NSC = SCAN_NC / SCAN_SC;
__device__ __forceinline__ void scan_pass1_units(const unsigned* au, f32x4* saggP, f32x4* saggH, f32x4* cpreP, f32x4* cpreH, LAS unsigned char* lds, const pg8::StaticOrder& S, int tid) {
    LAS f32x4* sP = (LAS f32x4*)lds; LAS f32x4* sH = sP + 2 * SCAN_SC * 32;
    const int ti = tid >> 8, cl = (tid >> 5) & 7, ql = tid & 31;
    for (int i0 = 0;; i0 += 2) {
        pg8::Unit u; const bool any = S.next(i0, u); if (!any) break;
        const bool mine = S.next(i0 + ti, u);
        const int pm = u.pm, c4 = ((u.pn >> 1) * 256 + (u.pn & 1) * 128) / 4 + ql, ck = pm * SCAN_SC + cl;
        f32x4 P = {1.f, 1.f, 1.f, 1.f}, Hh = {0.f, 0.f, 0.f, 0.f};
        if (mine) { const size_t off = (size_t)ck * SCAN_L * DM + 4 * c4;
#pragma unroll 16
            for (int t = 0; t < SCAN_L; ++t) { f32x4 a, uu; au_unpack(*(const u32x4*)(au + off + (size_t)t * DM), a, uu); Hh = a * Hh + uu; P = P * a; } }
        sP[(ti * SCAN_SC + cl) * 32 + ql] = P; sH[(ti * SCAN_SC + cl) * 32 + ql] = Hh;
        asm volatile("s_waitcnt lgkmcnt(0)" ::: "memory"); __syncthreads();
        f32x4 pP = {1.f, 1.f, 1.f, 1.f}, pH = {0.f, 0.f, 0.f, 0.f};
        for (int j = 0; j < cl; ++j) { const f32x4 p = sP[(ti * SCAN_SC + j) * 32 + ql], h = sH[(ti * SCAN_SC + j) * 32 + ql]; pH = p * pH + h; pP = pP * p; }
        if (mine) { cpreP[(size_t)ck * 256 + c4] = pP; cpreH[(size_t)ck * 256 + c4] = pH;
            if (cl == SCAN_SC - 1) { saggP[(size_t)pm * 256 + c4] = pP * P; saggH[(size_t)pm * 256 + c4] = P * pH + Hh; } }
        asm volatile("s_waitcnt lgkmcnt(0)" ::: "memory"); __syncthreads();
    }
}
__device__ __forceinline__ void scan_pass2_tile(const unsigned* au, const f32x4* saggP, const f32x4* saggH, const f32x4* cpreP, const f32x4* cpreH, const bf16_t* gate, bf16_t* y, int pm, int blk, int tid) {
    const int cl = tid >> 6, ql = tid & 63, b = pm / SCAN_NSC, c4 = blk * 64 + ql, ck = pm * SCAN_SC + cl;
    f32x4 C = {0.f, 0.f, 0.f, 0.f};
    for (int j = b * SCAN_NSC; j < pm; ++j) { const f32x4 p = saggP[(size_t)j * 256 + c4], h = saggH[(size_t)j * 256 + c4]; C = p * C + h; }
    f32x4 Hh = cpreP[(size_t)ck * 256 + c4] * C + cpreH[(size_t)ck * 256 + c4];
    const size_t off = (size_t)ck * SCAN_L * DM + 4 * c4;
#pragma unroll 16
    for (int t = 0; t < SCAN_L; ++t) { const size_t o = off + (size_t)t * DM; f32x4 a, u; au_unpack(*(const u32x4*)(au + o), a, u); const u32x2 gw2 = *(const u32x2*)(gate + o);
        Hh = a * Hh + u;
        u32x2 w; w.x = pk_bf16(Hh[0] * bf_lo(gw2.x), Hh[1] * bf_hi(gw2.x)); w.y = pk_bf16(Hh[2] * bf_lo(gw2.y), Hh[3] * bf_hi(gw2.y));
        *(u32x2*)(y + o) = w; }
}
__device__ __forceinline__ int crow16(int i, int h) { return (i & 3) + 8 * (i >> 2) + 4 * h; }
#define ATT_LOAD(KF, VF, kbi) do { const bf16_t* kp_ = kfrag + (size_t)(kbi) * 2048; const bf16_t* vp_ = vfrag + (size_t)(kbi) * 2048; \
    _Pragma("unroll") for (int s_ = 0; s_ < 4; ++s_) { KF[s_] = *(const bf16x8*)(kp_ + s_ * 512); VF[s_] = *(const bf16x8*)(vp_ + s_ * 512); } } while (0)
#define ATT_STEP(KF, VF, DIAG) do { \
    f32x16 pz; _Pragma("unroll") for (int i_ = 0; i_ < 16; ++i_) pz[i_] = 0.f; \
    _Pragma("unroll") for (int s_ = 0; s_ < 4; ++s_) pz = __builtin_amdgcn_mfma_f32_32x32x16_bf16(KF[s_], qf[s_], pz, 0, 0, 0); \
    float beta[16], f[16]; \
    _Pragma("unroll") for (int i_ = 0; i_ < 16; ++i_) { \
        const float bt_ = __builtin_amdgcn_rcpf(1.0f + __builtin_amdgcn_exp2f(-pz[i_]));     \
        const bool dead_ = (DIAG) && (crow16(i_, h) >= r);                                   \
        beta[i_] = dead_ ? 0.f : bt_; f[i_] = 1.0f - beta[i_]; } \
    float w[16]; float accp = R; \
    _Pragma("unroll") for (int g_ = 3; g_ >= 0; --g_) { \
        const float G_ = (f[4 * g_] * f[4 * g_ + 1]) * (f[4 * g_ + 2] * f[4 * g_ + 3]); \
        const auto rr_ = __builtin_amdgcn_permlane32_swap(__float_as_uint(G_), __float_as_uint(G_), false, false); \
        const float glo_ = __uint_as_float(rr_[0]), ghi_ = __uint_as_float(rr_[1]);          \
        float E_ = h ? accp : accp * ghi_; \
        accp = accp * (glo_ * ghi_); \
        w[4 * g_ + 3] = beta[4 * g_ + 3] * E_; E_ *= f[4 * g_ + 3]; \
        w[4 * g_ + 2] = beta[4 * g_ + 2] * E_; E_ *= f[4 * g_ + 2]; \
        w[4 * g_ + 1] = beta[4 * g_ + 1] * E_; E_ *= f[4 * g_ + 1]; \
        w[4 * g_] = beta[4 * g_] * E_; } \
    R = accp; \
    _Pragma("unroll") for (int s_ = 0; s_ < 2; ++s_) { \
        u32x4 t_; t_.x = pk_bf16(w[8 * s_], w[8 * s_ + 1]); t_.y = pk_bf16(w[8 * s_ + 2], w[8 * s_ + 3]); t_.z = pk_bf16(w[8 * s_ + 4], w[8 * s_ + 5]); t_.w = pk_bf16(w[8 * s_ + 6], w[8 * s_ + 7]); \
        const bf16x8 pw_ = __builtin_bit_cast(bf16x8, t_); \
        o0 = __builtin_amdgcn_mfma_f32_32x32x16_bf16(VF[s_], pw_, o0, 0, 0, 0); \
        o1 = __builtin_amdgcn_mfma_f32_32x32x16_bf16(VF[2 + s_], pw_, o1, 0, 0, 0); } } while (0)
__device__ __forceinline__ void attn_phase(const bf16_t* Q, const bf16_t* K, const bf16_t* VT, bf16_t* O, int gw, int ngw, int lane) {
    const int r = lane & 31, h = lane >> 5;
    constexpr int NQB = SEQ / 32;
    for (int unit = gw; unit < BATCH * NHEAD * NQB; unit += ngw) {
        const int bh = unit / NQB, qb = unit % NQB, b = bh / NHEAD, hd = bh % NHEAD;
        const bf16_t* qp = Q + ((size_t)(bh * NQB + qb) * 256 + lane) * 8;
        bf16x8 qf[4];
#pragma unroll
        for (int s = 0; s < 4; ++s) qf[s] = *(const bf16x8*)(qp + s * 512);
        const bf16_t* kfrag = K + ((size_t)bh * NQB * 256 + lane) * 8;
        const bf16_t* vfrag = VT + ((size_t)bh * NQB * 256 + lane) * 8;
        f32x16 o0, o1;
#pragma unroll
        for (int i = 0; i < 16; ++i) { o0[i] = 0.f; o1[i] = 0.f; }
        float R = 1.0f;
        bf16x8 kA[4], vA[4], kB[4], vB[4];
        ATT_LOAD(kA, vA, qb);
        for (int kb = qb;;) {
            ATT_LOAD(kB, vB, kb > 0 ? kb - 1 : 0);
            ATT_STEP(kA, vA, kb == qb);
            if (kb == 0 || !__any(R >= 1.17549435e-38f)) break;
            --kb;
            ATT_LOAD(kA, vA, kb > 0 ? kb - 1 : 0);
            ATT_STEP(kB, vB, false);
            if (kb == 0 || !__any(R >= 1.17549435e-38f)) break;
            --kb;
        }
        bf16_t* op = O + (size_t)(b * SEQ + qb * 32 + r) * DM + hd * HDIM + 4 * h;
#pragma unroll
        for (int g = 0; g < 4; ++g) {
            u32x2 w0; w0.x = pk_bf16(o0[4 * g], o0[4 * g + 1]); w0.y = pk_bf16(o0[4 * g + 2], o0[4 * g + 3]);
            u32x2 w1; w1.x = pk_bf16(o1[4 * g], o1[4 * g + 1]); w1.y = pk_bf16(o1[4 * g + 2], o1[4 * g + 3]);
            *(u32x2*)(op + 8 * g) = w0; *(u32x2*)(op + 32 + 8 * g) = w1;
        }
    }
}
#undef ATT_LOAD
#undef ATT_STEP

__device__ __forceinline__ void final_norm(float* x, const float* ssp, const float* g, int gw, int ngw, int lane) {
    f32x4 gv[4];
#pragma unroll
    for (int j = 0; j < 4; ++j) gv[j] = *((const f32x4*)g + lane + 64 * j);
    for (int m = gw; m < MTOK; m += ngw) {
        const float rs = row_rs(ssp, m);
        f32x4* xr = (f32x4*)(x + (size_t)m * DM) + lane;
#pragma unroll
        for (int j = 0; j < 4; ++j) xr[64 * j] = xr[64 * j] * rs * gv[j];
    }
}


#define XB_TMO      128
#define XB_XCNT(j)  (256  + 64 * (j))
#define XB_XSUB(j)  (1280 + 64 * (j))
#define XB_XGEN(j)  (2304 + 64 * (j))
#define XB_TOP      3328
#define XB_TOPGEN   3392
#define XCD_BAR_WORDS 3456
#define XB_SPIN_CAP (1u << 22)
__device__ __forceinline__ unsigned xb_ld(unsigned* p)              { return __hip_atomic_load(p, __ATOMIC_RELAXED, __HIP_MEMORY_SCOPE_AGENT); }
__device__ __forceinline__ unsigned xb_add(unsigned* p, unsigned v) { return __hip_atomic_fetch_add(p, v, __ATOMIC_RELAXED, __HIP_MEMORY_SCOPE_AGENT); }
__device__ __forceinline__ unsigned xb_xcc_id() { return (unsigned)__builtin_amdgcn_s_getreg((3 << 11) | 20) & 0xFu; }
#define XB_SPIN(cond, bar) do { unsigned _sp = 0; while (cond) { __builtin_amdgcn_s_sleep(1); \
    if ((++_sp & 255u) == 0u) { if (xb_ld(&(bar)[XB_TMO])) break; if (_sp > XB_SPIN_CAP) { atomicAdd(&(bar)[XB_TMO], 1u); break; } } } } while (0)
struct XcdBarrier { unsigned* bar; unsigned x; volatile LAS unsigned* st; };
__device__ __forceinline__ XcdBarrier xcd_barrier_post(unsigned* bar, volatile LAS unsigned* st, bool leader) {
    XcdBarrier b; b.bar = bar; b.x = xb_xcc_id(); b.st = st;
    if (leader) (void)xb_add(&bar[XB_XCNT(b.x)], 1u);
    return b;
}
__device__ __forceinline__ void xcd_barrier_complete(unsigned* bar, unsigned x, unsigned& nloc, unsigned& nx) {
    const unsigned G = gridDim.x * gridDim.y * gridDim.z;
    unsigned sum, cnt, mine, sp = 0u;
    for (;;) {
        sum = 0u; cnt = 0u; mine = 0u;
#pragma unroll
        for (unsigned j = 0; j < 16; ++j) { const unsigned c = xb_ld(&bar[XB_XCNT(j)]); sum += c; cnt += (c > 0u) ? 1u : 0u; mine = (j == x) ? c : mine; }
        if (sum == G) break;
        __builtin_amdgcn_s_sleep(1);
        if ((++sp & 255u) == 0u) { if (xb_ld(&bar[XB_TMO])) break; if (sp > XB_SPIN_CAP) { atomicAdd(&bar[XB_TMO], 1u); break; } }
    }
    nloc = mine > 0u ? mine : 1u; nx = cnt > 0u ? cnt : 1u;
}
__device__ __forceinline__ void xcd_barrier(const XcdBarrier& b, bool leader) {
    asm volatile("s_waitcnt vmcnt(0)" ::: "memory");
    __syncthreads();
    if (leader) {
        unsigned* bar = b.bar;
        __builtin_amdgcn_s_waitcnt(0);
        unsigned nloc = b.st[0], nx = b.st[1];
        if (nloc == 0u) { xcd_barrier_complete(bar, b.x, nloc, nx); b.st[0] = nloc; b.st[1] = nx; }
        const unsigned old = xb_add(&bar[XB_XSUB(b.x)], 1u);
        const unsigned gen = old / nloc;
        if (old + 1u == (gen + 1u) * nloc) {
            __builtin_amdgcn_fence(__ATOMIC_RELEASE, "agent");
            asm volatile("s_waitcnt vmcnt(0)" ::: "memory");
            const unsigned og = xb_add(&bar[XB_TOP], 1u);
            const unsigned tg = og / nx;
            if (og + 1u == (tg + 1u) * nx) xb_add(&bar[XB_TOPGEN], 1u);
        }
        XB_SPIN(xb_ld(&bar[XB_TOPGEN]) == gen, bar);
        __builtin_amdgcn_fence(__ATOMIC_ACQUIRE, "agent");
        asm volatile("s_waitcnt vmcnt(0)" ::: "memory");
    }
    __syncthreads();
}

constexpr int RST_OFF = 131072;
__device__ __forceinline__ int fill_rs_table(LAS unsigned char* lds, const float* ssp, const pg8::StaticOrder& S, int tid) {
    pg8::Unit u0; const int row_base = S.next(0, u0) ? (u0.pm / pg8::WGM) * pg8::WGM * pg8::BM : 0;
    LAS float* rst = (LAS float*)(lds + RST_OFF);
    for (int i = tid; i < pg8::WGM * pg8::BM; i += NTHREADS) rst[i] = row_rs(ssp, row_base + i);
    asm volatile("s_waitcnt lgkmcnt(0)" ::: "memory"); __syncthreads();
    return row_base;
}

__global__ void __launch_bounds__(NTHREADS, 2) fwd_megakernel(Params p) {
    extern __shared__ __attribute__((aligned(16))) unsigned char lds_raw[];
    LAS unsigned char* lds = (LAS unsigned char*)lds_raw;
    cg::grid_group grid = cg::this_grid();
    const int wave = __builtin_amdgcn_readfirstlane(threadIdx.x >> 6);
    const int G = gridDim.x, bx = blockIdx.x;
    const int vcu = (G % 8 == 0) ? (bx % 8) * (G / 8) + bx / 8 : bx;
    const int gw = vcu * NWAVES + wave, ngw = G * NWAVES, ngt = G * NTHREADS;
#define GT() (vcu * NTHREADS + wave * 64 + fresh_lane())
    unsigned char* ws = p.ws;
    volatile LAS unsigned* bst = (volatile LAS unsigned*)(lds + LDS_BYTES - 64);
    const bool leader = (wave == 0) && (fresh_lane() == 0);
    if (leader) { bst[0] = 0u; bst[1] = 0u; }
    XcdBarrier xbar = xcd_barrier_post((unsigned*)(ws + WS_CTL), bst, leader);
#define GSYNC() xcd_barrier(xbar, (wave == 0) && (fresh_lane() == 0))
    float* ssp = (float*)(ws + WS_SS);
    bf16_t* XB = (bf16_t*)(ws + WS_XB);
    bf16_t* R0 = (bf16_t*)(ws + WS_R0); bf16_t* R1 = (bf16_t*)(ws + WS_R1); bf16_t* R2 = (bf16_t*)(ws + WS_R2); bf16_t* R3 = (bf16_t*)(ws + WS_R3);
    unsigned* AU = (unsigned*)(ws + WS_R3);

    prologue(p, lds, gw, ngw, wave, fresh_lane());
    if (p.ws == nullptr) grid.sync();
    GSYNC();

    {   pg8::Gemm g{XB, (const bf16_t*)(ws + WS_WIN), MTOK, 2048, DM, DM, DM, 0}; pg8::StaticOrder S; S.init(MTOK, 2048, G, bx);
        const int rb = fill_rs_table(lds, ssp, S, wave * 64 + fresh_lane());
        pg8::EpiInProj E{R0, R1, (const LAS float*)(lds + RST_OFF), rb};
        pg8::gemm_phase<pg8::EpiInProj, pg8::StaticOrder, true, true>(lds, g, S, E, wave); }
    GSYNC();
    conv_phase(R1, p.in[4], p.in[5], R2, GT(), ngt);
    GSYNC();
    {   pg8::Gemm g{R2, (const bf16_t*)(ws + WS_WG), MTOK, 2048, 256, DM, 256, 1}; pg8::StaticOrder S; S.init(MTOK, 2048, G, bx);
        pg8::EpiGates E{R2, p.in[7], p.in[9], (const float*)(ws + WS_C8), AU};
        pg8::gemm_phase<pg8::EpiGates, pg8::StaticOrder, true, true>(lds, g, S, E, wave);
        asm volatile("s_waitcnt vmcnt(0)" ::: "memory"); __syncthreads();
        scan_pass1_units(AU, (f32x4*)(ws + WS_AGGP), (f32x4*)(ws + WS_AGGP + 512 * 1024), (f32x4*)(ws + WS_AGGH), (f32x4*)(ws + WS_CARRY), lds, S, wave * 64 + fresh_lane()); }
    GSYNC();
    for (int wi = bx; wi < (MTOK / 256) * 4; wi += G)
        scan_pass2_tile(AU, (const f32x4*)(ws + WS_AGGP), (const f32x4*)(ws + WS_AGGP + 512 * 1024), (const f32x4*)(ws + WS_AGGH), (const f32x4*)(ws + WS_CARRY), R0, R1, wi >> 2, wi & 3, wave * 64 + fresh_lane());
    GSYNC();
    {   pg8::Gemm g{R1, (const bf16_t*)(ws + WS_WOUT), MTOK, DM, DM, DM, DM, 0}; pg8::StaticOrder S; S.init(MTOK, DM, G, bx);
        pg8::EpiResid E{XB, ssp};
        pg8::gemm_phase<pg8::EpiResid, pg8::StaticOrder, false, true>(lds, g, S, E, wave); }
    GSYNC();
#pragma unroll
    for (int layer = 0; layer < 2; ++layer) {
        {   pg8::Gemm g{XB, (const bf16_t*)(ws + (layer ? WS_WGU1 : WS_WGU0)), MTOK, 2 * DFF, DM, DM, DM, 0}; pg8::StaticOrder S; S.init(MTOK, 2 * DFF, G, bx);
            const int rb = fill_rs_table(lds, ssp, S, wave * 64 + fresh_lane());
            pg8::EpiSwiglu E{R0, (const LAS float*)(lds + RST_OFF), rb};
            pg8::gemm_phase<pg8::EpiSwiglu, pg8::StaticOrder, true, true>(lds, g, S, E, wave);
            {   pg8::Unit ul; const int rounds = (S.nwg + G - 1) / G;
                if (S.nwg % G != 0 && !S.next(rounds - 1, ul)) { const int nidle = G - S.nwg % G, rank = bx - S.nwg % G;
                    if (layer == 0) convert_weights<1>(p, lds, rank * NWAVES + wave, nidle * NWAVES, wave, fresh_lane());
                    else convert_weights<2>(p, lds, rank * NWAVES + wave, nidle * NWAVES, wave, fresh_lane()); } } }
        GSYNC();
        {   pg8::Gemm g{R0, (const bf16_t*)(ws + (layer ? WS_WD1 : WS_WD0)), MTOK, DM, DFF, DFF, DFF, 0}; pg8::StaticOrder S; S.init(MTOK, DM, G, bx);
            if (layer == 0) { pg8::EpiResid E{XB, ssp}; pg8::gemm_phase<pg8::EpiResid, pg8::StaticOrder, false, true>(lds, g, S, E, wave); }
            else { pg8::EpiFinal E{XB, ssp, (unsigned*)(ws + WS_PCNT), p.in[17], p.out}; pg8::gemm_phase<pg8::EpiFinal, pg8::StaticOrder, false, true>(lds, g, S, E, wave); } }
        if (layer == 0) {
            GSYNC();
            {   pg8::Gemm g{XB, (const bf16_t*)(ws + WS_WQKV), MTOK, 3072, DM, DM, DM, 0, (const bf16_t*)(ws + WS_WQKV) + (size_t)2048 * DM, XB, 8}; pg8::StaticOrder S; S.init(MTOK, 3072, G, bx);
                const int rb = fill_rs_table(lds, ssp, S, wave * 64 + fresh_lane());
                pg8::EpiQKV E{pg8::EpiQK{R0, R1, (const LAS float*)(lds + RST_OFF), rb, 0.125f * LOG2E}, pg8::EpiVT{R2, (const LAS float*)(lds + RST_OFF), rb}};
                pg8::gemm_phase<pg8::EpiQKV, pg8::StaticOrder, true, true>(lds, g, S, E, wave); }
            GSYNC();
            attn_phase(R0, R1, R2, R3, gw, ngw, fresh_lane());
            GSYNC();
            {   pg8::Gemm g{R3, (const bf16_t*)(ws + WS_WBO), MTOK, DM, DM, DM, DM, 0}; pg8::StaticOrder S; S.init(MTOK, DM, G, bx);
                pg8::EpiResid E{XB, ssp};
                pg8::gemm_phase<pg8::EpiResid, pg8::StaticOrder, false, true>(lds, g, S, E, wave); }
            GSYNC();
        }
    }
}

extern "C" void kernel_launch(void* const* d_in, const int* in_sizes, int n_in, void* d_out, int out_size, void* d_ws, size_t ws_size, hipStream_t stream) {
    static int grid = 0;
    if (grid == 0) {
        if (n_in != 18 || out_size != MTOK * DM || ws_size < WS_END) { fprintf(stderr, "kernel_launch: unexpected shapes (n_in %d, out %d, ws %zu)\n", n_in, out_size, ws_size); grid = -1; return; }
        int dev = 0, cus = 0, per_cu = 0;
        (void)hipGetDevice(&dev); (void)hipDeviceGetAttribute(&cus, hipDeviceAttributeMultiprocessorCount, dev);
        if (hipFuncSetAttribute((const void*)fwd_megakernel, hipFuncAttributeMaxDynamicSharedMemorySize, LDS_BYTES) != hipSuccess) { fprintf(stderr, "kernel_launch: hipFuncSetAttribute failed\n"); grid = -1; return; }
        if (hipOccupancyMaxActiveBlocksPerMultiprocessor(&per_cu, (const void*)fwd_megakernel, NTHREADS, LDS_BYTES) != hipSuccess || per_cu < 1) { fprintf(stderr, "kernel_launch: occupancy query says %d blocks per CU\n", per_cu); per_cu = 1; }
        (void)hipGetLastError();
        grid = cus;
        if (grid != 256) fprintf(stderr, "kernel_launch: %d CUs; this kernel is built for 256\n", grid);
    }
    if (grid < 0) return;
    if (hipMemsetAsync((char*)d_ws + WS_CTL, 0, CTL_BYTES, stream) != hipSuccess) { fprintf(stderr, "kernel_launch: hipMemsetAsync failed\n"); return; }
    Params p{};
    for (int i = 0; i < 18; ++i) p.in[i] = (const float*)d_in[i];
    p.out = (float*)d_out; p.ws = (unsigned char*)d_ws;
    void* args[] = {&p};
    const hipError_t e = hipLaunchCooperativeKernel((const void*)fwd_megakernel, dim3(grid), dim3(NTHREADS), args, LDS_BYTES, stream);
    if (e != hipSuccess) fprintf(stderr, "kernel_launch: cooperative launch failed: %s (grid %d)\n", hipGetErrorString(e), grid);
}
```

```cpp
#include <hip/hip_runtime.h>
#include <hip/hip_cooperative_groups.h>
#include <cstdio>
#include <cstdint>
namespace cg = cooperative_groups;

#define LAS __attribute__((address_space(3)))
typedef unsigned short bf16_t;
typedef short bf16x8 __attribute__((ext_vector_type(8)));
typedef short s16x4 __attribute__((ext_vector_type(4)));
typedef float f32x2 __attribute__((ext_vector_type(2)));
typedef float f32x4 __attribute__((ext_vector_type(4)));
typedef float f32x16 __attribute__((ext_vector_type(16)));
typedef unsigned u32x2 __attribute__((ext_vector_type(2)));
typedef unsigned u32x4 __attribute__((ext_vector_type(4)));
typedef __bf16 bf16v2 __attribute__((ext_vector_type(2)));

constexpr int BATCH = 2, SEQ = 8192, DM = 1024, MTOK = BATCH * SEQ, DFF = 2816, NHEAD = 16, HDIM = 64;
constexpr float RMS_EPS = 1e-6f;
constexpr float LOG2E = 1.4426950408889634f;

__device__ __forceinline__ unsigned pk_bf16(float lo, float hi) { f32x2 v = {lo, hi}; return __builtin_bit_cast(unsigned, __builtin_convertvector(v, bf16v2)); }
typedef _Float16 f16v2 __attribute__((ext_vector_type(2)));
__device__ __forceinline__ unsigned pk_f16(float lo, float hi) { f32x2 v = {lo, hi}; return __builtin_bit_cast(unsigned, __builtin_convertvector(v, f16v2)); }
__device__ __forceinline__ f32x2 unpk_f16(unsigned w) { return __builtin_convertvector(__builtin_bit_cast(f16v2, w), f32x2); }
__device__ __forceinline__ float bf_lo(unsigned w) { return __uint_as_float(w << 16); }
__device__ __forceinline__ float bf_hi(unsigned w) { return __uint_as_float(w & 0xffff0000u); }
__device__ __forceinline__ float fast_sigmoid(float v) { return __builtin_amdgcn_rcpf(1.0f + __builtin_amdgcn_exp2f(-v * LOG2E)); }
__device__ __forceinline__ float gelu_tanh(float x) { const float y2 = x * (1.5957691216057308f + 0.07135481627f * x * x); return x * __builtin_amdgcn_rcpf(1.0f + __builtin_amdgcn_exp2f(-y2 * LOG2E)); }
__device__ __forceinline__ int fresh_lane() { int l; asm volatile("v_mbcnt_lo_u32_b32 %0, -1, 0\n\tv_mbcnt_hi_u32_b32 %0, -1, %0" : "=v"(l)); return l; }
__device__ __forceinline__ float wave_sum(float v) {
#pragma unroll
    for (int o = 1; o < 64; o <<= 1) v += __shfl_xor(v, o);
    return v;
}
__device__ __forceinline__ float row_rs(const float* ssp, int row) { const f32x4 s = *(const f32x4*)(ssp + (size_t)row * 4); return rsqrtf(((s[0] + s[1]) + (s[2] + s[3])) * (1.0f / DM) + RMS_EPS); }

namespace pg8 {
#define PG8_LAS __attribute__((address_space(3)))
constexpr int BM = 256, BK = 64, HALF = 128, HTB = HALF * BK * 2  , STAGE_BYTES = 8 * HTB, NXCD = 8, WGM = 8;

__host__ __device__ __forceinline__ int lds_byte(int r, int c) { const int st = (r >> 4) * 2 + (c >> 5), rr = r & 15, cc = c & 31, ob = rr * 64 + cc * 2; return st * 1024 + (ob ^ (((ob >> 9) & 1) << 5)); }
__host__ __device__ __forceinline__ void stage_rc(int b, int& R, int& C) { const int st = b / 1024, sb = b % 1024, swz = sb ^ (((sb >> 9) & 1) << 5); R = (st >> 1) * 16 + swz / 64; C = (st & 1) * 32 + (swz % 64) / 2; }
__host__ __device__ __forceinline__ int perm32(int rho) { const int n = rho >> 4, i = rho & 15; return 8 * (i >> 2) + 4 * n + (i & 3); }

struct Unit { int pm, pn; };
struct Gemm { const bf16_t* A; const bf16_t* Bt; int M, N, K, lda, ldb, bd; const bf16_t* A2 = nullptr; const bf16_t* B2 = nullptr; int swap_pn = 1 << 30; };

struct StaticOrder {
    int nM, nN, nwg, G, c;
    __host__ __device__ void init(int M, int N, int G_, int c_) { nM = M / BM; nN = N / BM; nwg = nM * nN; G = G_; c = c_; }
    __host__ __device__ bool next(int i, Unit& u) const {
        const long L = (long)i * G + c; if (L >= nwg) return false;
        int wgid = (int)L; { const int q = nwg / NXCD, r = nwg % NXCD, xcd = wgid % NXCD, off = wgid / NXCD; wgid = (xcd < r ? xcd * (q + 1) : r * (q + 1) + (xcd - r) * q) + off; }
        const int nig = WGM * nN, gid = wgid / nig, fm = gid * WGM, gsz = (nM - fm) < WGM ? (nM - fm) : WGM;
        u.pm = fm + ((wgid % nig) % gsz); u.pn = (wgid % nig) / gsz; return true;
    }
    __device__ __forceinline__ void a_ready(const Unit&) const {}
    __device__ __forceinline__ void done(const Unit&) const {}
};

typedef f32x4 AccT[2][2][4][2];

struct EpiInProj {
    static constexpr bool PERM = true, AFTER_DRAIN = false, ACC_INIT = false;
    bf16_t* gate; bf16_t* xbr; const LAS float* rst; int row_base;
    __device__ __forceinline__ void operator()(const AccT& acc, const Unit& u, int wr, int wc, int fr, int fq) const {
        const bool isgate = u.pn < 4;
        bf16_t* base = isgate ? gate : xbr;
        const int row0 = u.pm * BM + wr * 64 + fr, col0 = (u.pn & 3) * BM + wc * 32 + 8 * fq;
#pragma unroll
        for (int ai = 0; ai < 2; ++ai)
#pragma unroll
            for (int m = 0; m < 4; ++m) { const int row = row0 + ai * HALF + m * 16; const float rs = rst[row - row_base]; bf16_t* rowp = base + (size_t)row * DM + col0;
#pragma unroll
                for (int bj = 0; bj < 2; ++bj) { f32x4 v0 = acc[ai][bj][m][0] * rs, v1 = acc[ai][bj][m][1] * rs;
                    if (isgate) {
#pragma unroll
                        for (int e = 0; e < 4; ++e) { v0[e] = gelu_tanh(v0[e]); v1[e] = gelu_tanh(v1[e]); } }
                    u32x4 w; w.x = pk_bf16(v0[0], v0[1]); w.y = pk_bf16(v0[2], v0[3]); w.z = pk_bf16(v1[0], v1[1]); w.w = pk_bf16(v1[2], v1[3]);
                    *(u32x4*)(rowp + bj * HALF) = w; } }
    }
};

struct EpiGates {
    static constexpr bool PERM = true, AFTER_DRAIN = false, ACC_INIT = false;
    const bf16_t* xc; const float* b_r; const float* b_i; const float* c8t; unsigned* au_out;
    __device__ __forceinline__ void operator()(const AccT& acc, const Unit& u, int wr, int wc, int fr, int fq) const {
        const int ch0 = (u.pn >> 1) * 256 + (u.pn & 1) * 128 + wc * 32 + 8 * fq, row0 = u.pm * BM + wr * 64 + fr;
        f32x4 br[2], bi[2], c8[2];
#pragma unroll
        for (int n = 0; n < 2; ++n) { br[n] = *(const f32x4*)(b_r + ch0 + 4 * n); bi[n] = *(const f32x4*)(b_i + ch0 + 4 * n); c8[n] = *(const f32x4*)(c8t + ch0 + 4 * n); }
#pragma unroll
        for (int ai = 0; ai < 2; ++ai)
#pragma unroll
            for (int m = 0; m < 4; ++m) { const unsigned off = (unsigned)(row0 + ai * HALF + m * 16) * DM + ch0;
                const u32x4 xw = __builtin_nontemporal_load((const u32x4*)(xc + off));
                const float xv[8] = {bf_lo(xw.x), bf_hi(xw.x), bf_lo(xw.y), bf_hi(xw.y), bf_lo(xw.z), bf_hi(xw.z), bf_lo(xw.w), bf_hi(xw.w)};
                u32x4 pk[2];
#pragma unroll
                for (int n = 0; n < 2; ++n)
#pragma unroll
                    for (int e = 0; e < 4; ++e) {
                        const float rr = fast_sigmoid(acc[ai][0][m][n][e] + br[n][e]), ii = fast_sigmoid(acc[ai][1][m][n][e] + bi[n][e]);
                        const float la = c8[n][e] * rr, a = __builtin_amdgcn_exp2f(la * LOG2E), x2 = 2.0f * la;
                        const float ser = -x2 * (1.0f + x2 * (0.5f + x2 * (0.16666667f + x2 * 0.041666668f)));
                        const float m2 = x2 > -0.06f ? ser : 1.0f - a * a;
                        pk[n][e] = pk_f16(la * (LOG2E * 1024.0f), __builtin_amdgcn_sqrtf(fmaxf(m2, 0.f)) * (ii * xv[4 * n + e])); }
                *(u32x4*)(au_out + off) = pk[0]; *(u32x4*)(au_out + off + 4) = pk[1];
                asm volatile("" ::: "memory"); }
    }
};

struct EpiSwiglu {
    static constexpr bool PERM = true, AFTER_DRAIN = false, ACC_INIT = false;
    bf16_t* hid; const LAS float* rst; int row_base;
    __device__ __forceinline__ void operator()(const AccT& acc, const Unit& u, int wr, int wc, int fr, int fq) const {
        const int row0 = u.pm * BM + wr * 64 + fr, col0 = u.pn * HALF + wc * 32 + 8 * fq;
#pragma unroll
        for (int ai = 0; ai < 2; ++ai)
#pragma unroll
            for (int m = 0; m < 4; ++m) { const int row = row0 + ai * HALF + m * 16; const float rs = rst[row - row_base];
                float hv[8];
#pragma unroll
                for (int n = 0; n < 2; ++n)
#pragma unroll
                    for (int e = 0; e < 4; ++e) { const float g = acc[ai][0][m][n][e] * rs, uu = acc[ai][1][m][n][e] * rs; hv[4 * n + e] = g * fast_sigmoid(g) * uu; }
                u32x4 w; w.x = pk_bf16(hv[0], hv[1]); w.y = pk_bf16(hv[2], hv[3]); w.z = pk_bf16(hv[4], hv[5]); w.w = pk_bf16(hv[6], hv[7]);
                *(u32x4*)(hid + (size_t)row * DFF + col0) = w; }
    }
};

struct EpiQK {
    static constexpr bool PERM = true, AFTER_DRAIN = false, ACC_INIT = false;
    bf16_t* q; bf16_t* k; const LAS float* rst; int row_base; float qscale;
    __device__ __forceinline__ void operator()(const AccT& acc, const Unit& u, int wr, int wc, int fr, int fq) const {
        const bool isq = u.pn < 4; bf16_t* base = isq ? q : k; const float sc = isq ? qscale : 1.0f;
        const int row0 = u.pm * BM + wr * 64 + fr, col0 = (u.pn & 3) * BM + wc * 32 + 8 * fq;
#pragma unroll
        for (int ai = 0; ai < 2; ++ai)
#pragma unroll
            for (int m = 0; m < 4; ++m) { const int row = row0 + ai * HALF + m * 16; const float rs = rst[row - row_base] * sc;
                const unsigned b = (unsigned)row >> 13, t = (unsigned)row & 8191u;
#pragma unroll
                for (int bj = 0; bj < 2; ++bj) { const f32x4 v0 = acc[ai][bj][m][0] * rs, v1 = acc[ai][bj][m][1] * rs;
                    const unsigned col = col0 + bj * HALF, hd = col >> 6, d0 = col & 63u;
                    const unsigned off = ((((b * NHEAD + hd) * 256u + (t >> 5)) * 4u + (d0 >> 4)) * 64u + ((d0 >> 3) & 1u) * 32u + (t & 31u)) * 8u;
                    u32x4 w; w.x = pk_bf16(v0[0], v0[1]); w.y = pk_bf16(v0[2], v0[3]); w.z = pk_bf16(v1[0], v1[1]); w.w = pk_bf16(v1[2], v1[3]);
                    *(u32x4*)(base + off) = w; } }
    }
};

struct EpiVT {
    static constexpr bool PERM = true, AFTER_DRAIN = false, ACC_INIT = false;
    bf16_t* vt; const LAS float* rst; int row_base;
    __device__ __forceinline__ void operator()(const AccT& acc, const Unit& u, int wr, int wc, int fr, int fq) const {
        const int row0 = u.pm * BM + wr * 64 + fr, tok0 = u.pn * BM + wc * 32 + 8 * fq;
        float rsv[2][8];
#pragma unroll
        for (int bj = 0; bj < 2; ++bj)
#pragma unroll
            for (int j = 0; j < 8; ++j) rsv[bj][j] = rst[tok0 + bj * HALF + j - row_base];
#pragma unroll
        for (int ai = 0; ai < 2; ++ai)
#pragma unroll
            for (int m = 0; m < 4; ++m) { const unsigned row = row0 + ai * HALF + m * 16, hd = row >> 6, d = row & 63u;
#pragma unroll
                for (int bj = 0; bj < 2; ++bj) { const f32x4 a0 = acc[ai][bj][m][0], a1 = acc[ai][bj][m][1];
                    const unsigned tok = tok0 + bj * HALF, b = tok >> 13, t = tok & 8191u;
                    const unsigned off = (((((b * NHEAD + hd) * 256u + (t >> 5)) * 2u + (d >> 5)) * 2u + ((t >> 4) & 1u)) * 64u + (d & 31u)) * 8u + 4u * ((t >> 3) & 1u);
                    u32x2 w0, w1; w0.x = pk_bf16(a0[0] * rsv[bj][0], a0[1] * rsv[bj][1]); w0.y = pk_bf16(a0[2] * rsv[bj][2], a0[3] * rsv[bj][3]);
                    w1.x = pk_bf16(a1[0] * rsv[bj][4], a1[1] * rsv[bj][5]); w1.y = pk_bf16(a1[2] * rsv[bj][6], a1[3] * rsv[bj][7]);
                    *(u32x2*)(vt + off) = w0; *(u32x2*)(vt + off + 32 * 8) = w1; } }
    }
};

struct EpiQKV {
    static constexpr bool PERM = true, AFTER_DRAIN = false, ACC_INIT = false;
    EpiQK qk; EpiVT vt;
    __device__ __forceinline__ void operator()(const AccT& acc, const Unit& u, int wr, int wc, int fr, int fq) const {
        if (u.pn >= 8) { const Unit ut{u.pn - 8, u.pm}; vt(acc, ut, wr, wc, fr, fq); } else qk(acc, u, wr, wc, fr, fq);
    }
};

__device__ __forceinline__ void acc_from_xb(AccT& acc, const bf16_t* xb, const Unit& u, int wr, int wc, int fr, int fq) {
    const unsigned off0 = (unsigned)(u.pm * BM + wr * 64 + fr) * DM + u.pn * BM + wc * 32 + 8 * fq;
#pragma unroll
    for (int ai = 0; ai < 2; ++ai)
#pragma unroll
        for (int m = 0; m < 4; ++m)
#pragma unroll
            for (int bj = 0; bj < 2; ++bj) { const u32x4 w = *(const u32x4*)(xb + off0 + (unsigned)(ai * HALF + m * 16) * DM + bj * HALF);
                acc[ai][bj][m][0] = (f32x4){bf_lo(w.x), bf_hi(w.x), bf_lo(w.y), bf_hi(w.y)}; acc[ai][bj][m][1] = (f32x4){bf_lo(w.z), bf_hi(w.z), bf_lo(w.w), bf_hi(w.w)}; }
}
__device__ __forceinline__ void tile_row_ss(const AccT& acc, PG8_LAS float* P, int wr, int wc, int fr, int fq) {
#pragma unroll
    for (int ai = 0; ai < 2; ++ai)
#pragma unroll
        for (int m = 0; m < 4; ++m) { float ss = 0.f;
#pragma unroll
            for (int bj = 0; bj < 2; ++bj) { const f32x4 v0 = acc[ai][bj][m][0], v1 = acc[ai][bj][m][1];
                ss += (v0[0] * v0[0] + v0[1] * v0[1]) + (v0[2] * v0[2] + v0[3] * v0[3]) + (v1[0] * v1[0] + v1[1] * v1[1]) + (v1[2] * v1[2] + v1[3] * v1[3]); }
            ss += __shfl_xor(ss, 16); ss += __shfl_xor(ss, 32);
            if (fq == 0) P[(ai * HALF + wr * 64 + m * 16 + fr) * 4 + wc] = ss; }
}
struct EpiResid {
    static constexpr bool PERM = true, AFTER_DRAIN = true, ACC_INIT = true;
    bf16_t* xb; float* ssp;
    __device__ __forceinline__ void init(AccT& acc, const Unit& u, int wr, int wc, int fr, int fq) const { acc_from_xb(acc, xb, u, wr, wc, fr, fq); }
    __device__ __forceinline__ void fused(AccT& acc, const Unit& u, int wr, int wc, int fr, int fq, PG8_LAS unsigned char* lds, int wid, int lane) const {
        PG8_LAS float* P = (PG8_LAS float*)lds;
        const unsigned off0 = (unsigned)(u.pm * BM + wr * 64 + fr) * DM + u.pn * BM + wc * 32 + 8 * fq;
#pragma unroll
        for (int ai = 0; ai < 2; ++ai)
#pragma unroll
            for (int m = 0; m < 4; ++m)
#pragma unroll
                for (int bj = 0; bj < 2; ++bj) { const f32x4 v0 = acc[ai][bj][m][0], v1 = acc[ai][bj][m][1];
                    u32x4 w; w.x = pk_bf16(v0[0], v0[1]); w.y = pk_bf16(v0[2], v0[3]); w.z = pk_bf16(v1[0], v1[1]); w.w = pk_bf16(v1[2], v1[3]);
                    *(u32x4*)(xb + off0 + (unsigned)(ai * HALF + m * 16) * DM + bj * HALF) = w; }
        tile_row_ss(acc, P, wr, wc, fr, fq);
        asm volatile("s_waitcnt lgkmcnt(0)" ::: "memory"); __builtin_amdgcn_s_barrier(); asm volatile("" ::: "memory");
        const int tid = wid * 64 + lane;
        if (tid < 256) { const f32x4 p = *(const PG8_LAS f32x4*)(P + tid * 4); ssp[(size_t)(u.pm * BM + tid) * 4 + u.pn] = (p[0] + p[1]) + (p[2] + p[3]); }
    }
};
struct EpiFinal {
    static constexpr bool PERM = true, AFTER_DRAIN = true, ACC_INIT = true;
    const bf16_t* xb; float* ssp; unsigned* cnt; const float* g; float* out;
    __device__ __forceinline__ void init(AccT& acc, const Unit& u, int wr, int wc, int fr, int fq) const { acc_from_xb(acc, xb, u, wr, wc, fr, fq); }
    __device__ __forceinline__ void fused(AccT& acc, const Unit& u, int wr, int wc, int fr, int fq, PG8_LAS unsigned char* lds, int wid, int lane) const {
        PG8_LAS float* P = (PG8_LAS float*)lds;
        PG8_LAS float* RS = (PG8_LAS float*)(lds + 4096);
        tile_row_ss(acc, P, wr, wc, fr, fq);
        asm volatile("s_waitcnt lgkmcnt(0)" ::: "memory"); __builtin_amdgcn_s_barrier(); asm volatile("" ::: "memory");
        const int tid = wid * 64 + lane;
        if (tid < 256) { const f32x4 p = *(const PG8_LAS f32x4*)(P + tid * 4);
            __hip_atomic_store(ssp + (size_t)(u.pm * BM + tid) * 4 + u.pn, (p[0] + p[1]) + (p[2] + p[3]), __ATOMIC_RELAXED, __HIP_MEMORY_SCOPE_AGENT); }
        asm volatile("s_waitcnt vmcnt(0)" ::: "memory");
        unsigned* c = cnt + 64 * u.pm;
        if (lane == 0) __hip_atomic_fetch_add(c, 1u, __ATOMIC_RELAXED, __HIP_MEMORY_SCOPE_AGENT);
        if (wid == 0) {
            unsigned sp = 0;
            while ((unsigned)__builtin_amdgcn_readfirstlane(__hip_atomic_load(c, __ATOMIC_RELAXED, __HIP_MEMORY_SCOPE_AGENT)) < 32u) { __builtin_amdgcn_s_sleep(2); if (++sp > (1u << 24)) break; }
            __builtin_amdgcn_fence(__ATOMIC_ACQUIRE, "agent");
        }
        asm volatile("s_waitcnt vmcnt(0) lgkmcnt(0)" ::: "memory"); __builtin_amdgcn_s_barrier(); asm volatile("" ::: "memory");
        if (tid < 256) { const float* sl = ssp + (size_t)(u.pm * BM + tid) * 4; float s = 0.f;
#pragma unroll
            for (int t = 0; t < 4; ++t) s += __hip_atomic_load(sl + t, __ATOMIC_RELAXED, __HIP_MEMORY_SCOPE_AGENT);
            RS[tid] = rsqrtf(s * (1.0f / DM) + RMS_EPS); }
        asm volatile("s_waitcnt vmcnt(0) lgkmcnt(0)" ::: "memory"); __builtin_amdgcn_s_barrier(); asm volatile("" ::: "memory");
        const int col0 = u.pn * BM + wc * 32 + 8 * fq;
        f32x4 gv[2][2];
#pragma unroll
        for (int bj = 0; bj < 2; ++bj) { gv[bj][0] = *(const f32x4*)(g + col0 + bj * HALF); gv[bj][1] = *(const f32x4*)(g + col0 + bj * HALF + 4); }
#pragma unroll
        for (int ai = 0; ai < 2; ++ai)
#pragma unroll
            for (int m = 0; m < 4; ++m) { const int rl = ai * HALF + wr * 64 + m * 16 + fr; const float rs = RS[rl]; float* op = out + (size_t)(u.pm * BM + rl) * DM + col0;
#pragma unroll
                for (int bj = 0; bj < 2; ++bj) { *(f32x4*)(op + bj * HALF) = acc[ai][bj][m][0] * rs * gv[bj][0]; *(f32x4*)(op + bj * HALF + 4) = acc[ai][bj][m][1] * rs * gv[bj][1]; } }
    }
};

template <class Epi, class Sched, bool ALIGN_EPI = false, bool SP2 = false>
__device__ __forceinline__ void gemm_phase(PG8_LAS unsigned char* lds, const Gemm g, const Sched& S, const Epi& E, const int wid) {
    const int lane = fresh_lane(), tid = wid * 64 + lane, wr = wid >> 2, wc = wid & 3, fr = lane & 15, fq = lane >> 4;
    int nt = g.K / BK; asm volatile("" : "+s"(nt));
    unsigned voffA[2], voffB[2];
#pragma unroll
    for (int i = 0; i < 2; ++i) { int R, C; stage_rc(tid * 16 + i * 8192, R, C); const int Rb = Epi::PERM ? ((R & ~31) + perm32(R & 31)) : R;
        voffA[i] = (unsigned)(R * g.lda + C) * 2u; voffB[i] = (unsigned)(Rb * g.ldb + C) * 2u; }
    const size_t kstep = (size_t)(BK * 2);
    const size_t hstepA = (size_t)HALF * g.lda * 2, hstepB = (size_t)HALF * g.ldb * 2;
    const size_t tstepA = 2 * hstepA, tstepB = 2 * hstepB;
    const unsigned ldsw = (unsigned)wid * 1024u;
    const int aoff = lds_byte(wr * 64 + fr, fq * 8), boff = lds_byte(wc * 32 + fr, fq * 8);
#define PG8_SA(b, h) (((b) * 2 + (h)) * HTB)
#define PG8_SB(b, h) ((4 + (b) * 2 + (h)) * HTB)
#define PG8_STAGE(bufoff, gbase, voff) do { _Pragma("unroll") for (int _i = 0; _i < 2; ++_i) \
        __builtin_amdgcn_global_load_lds((const unsigned*)((const char*)(gbase) + (voff)[_i]), (PG8_LAS unsigned*)(lds + (bufoff) + ldsw + _i * 8192), 16, 0, 0); } while (0)
#define PG8_LDA(dst, b, h) do { _Pragma("unroll") for (int m = 0; m < 4; ++m) _Pragma("unroll") for (int k = 0; k < 2; ++k) dst[m][k] = *(const PG8_LAS bf16x8*)(lds + PG8_SA(b, h) + aoff + m * 2048 + k * 1024); } while (0)
#define PG8_LDB(dst, b, h) do { _Pragma("unroll") for (int n = 0; n < 2; ++n) _Pragma("unroll") for (int k = 0; k < 2; ++k) dst[n][k] = *(const PG8_LAS bf16x8*)(lds + PG8_SB(b, h) + boff + n * 2048 + k * 1024); } while (0)
#define PG8_MMA(ai, bj, At, Bt) do { __builtin_amdgcn_s_setprio(1); _Pragma("unroll") for (int m = 0; m < 4; ++m) _Pragma("unroll") for (int n = 0; n < 2; ++n) _Pragma("unroll") for (int k = 0; k < 2; ++k) \
        acc[ai][bj][m][n] = __builtin_amdgcn_mfma_f32_16x16x32_bf16(Bt[n][k], At[m][k], acc[ai][bj][m][n], 0, 0, 0); __builtin_amdgcn_s_setprio(0); } while (0)
#define PG8_WAIT_V(n) asm volatile("s_waitcnt vmcnt(" #n ")" ::: "memory")
#define PG8_WAIT_L(n) asm volatile("s_waitcnt lgkmcnt(" #n ")" ::: "memory")
#define PG8_BAR __builtin_amdgcn_s_barrier()
#define PG8_SCHED __builtin_amdgcn_sched_barrier(0)
    Unit cur, nxt; int ui = 0;
    if (!S.next(0, cur)) return;
    f32x4 acc[2][2][4][2];
    if constexpr (Epi::ACC_INIT) E.init(acc, cur, wr, wc, fr, fq);
    else {
#pragma unroll
    for (int a = 0; a < 2; ++a)
#pragma unroll
        for (int b = 0; b < 2; ++b)
#pragma unroll
            for (int m = 0; m < 4; ++m)
#pragma unroll
                for (int n = 0; n < 2; ++n) acc[a][b][m][n] = (f32x4){0.f, 0.f, 0.f, 0.f};
    }
    bf16x8 At[4][2], B0[2][2], B1[2][2];
    const char* cA = cur.pn >= g.swap_pn ? (const char*)g.A2 + (size_t)(cur.pn - g.swap_pn) * tstepA : (const char*)g.A + (size_t)cur.pm * tstepA + (g.bd ? (size_t)(cur.pn >> 1) * 512 : 0);
    const char* cB = cur.pn >= g.swap_pn ? (const char*)g.B2 + (size_t)cur.pm * tstepB : (const char*)g.Bt + (size_t)cur.pn * tstepB;
    S.a_ready(cur);
    if constexpr (SP2) {
        PG8_STAGE(PG8_SB(0, 0), cB, voffB); PG8_STAGE(PG8_SB(0, 1), cB + hstepB, voffB); PG8_STAGE(PG8_SA(0, 0), cA, voffA); PG8_STAGE(PG8_SA(0, 1), cA + hstepA, voffA);
        if (wr == 1) PG8_BAR;
        PG8_WAIT_V(2); PG8_BAR;
        PG8_STAGE(PG8_SB(1, 0), cB + kstep, voffB); PG8_STAGE(PG8_SA(1, 0), cA + kstep, voffA); PG8_STAGE(PG8_SB(1, 1), cB + hstepB + kstep, voffB);
        PG8_WAIT_V(6); PG8_BAR;
    } else {
        PG8_STAGE(PG8_SB(0, 0), cB, voffB); PG8_STAGE(PG8_SA(0, 0), cA, voffA); PG8_STAGE(PG8_SB(0, 1), cB + hstepB, voffB); PG8_STAGE(PG8_SA(0, 1), cA + hstepA, voffA);
        if (wr == 1) PG8_BAR;
        PG8_WAIT_V(4); PG8_BAR;
        PG8_STAGE(PG8_SB(1, 0), cB + kstep, voffB); PG8_STAGE(PG8_SA(1, 0), cA + kstep, voffA); PG8_STAGE(PG8_SB(1, 1), cB + hstepB + kstep, voffB);
        PG8_WAIT_V(6); PG8_BAR;
    }
    for (;;) {
        const bool has_next = S.next(ui + 1, nxt);
        const char* nA = !has_next ? cA : nxt.pn >= g.swap_pn ? (const char*)g.A2 + (size_t)(nxt.pn - g.swap_pn) * tstepA : (const char*)g.A + (size_t)nxt.pm * tstepA + (g.bd ? (size_t)(nxt.pn >> 1) * 512 : 0);
        const char* nB = !has_next ? cB : nxt.pn >= g.swap_pn ? (const char*)g.B2 + (size_t)nxt.pm * tstepB : (const char*)g.Bt + (size_t)nxt.pn * tstepB;
        for (int t = 0; t < nt; t += 2) {
            const bool last = (t == nt - 2);
            const char* a1 = cA + (size_t)(t + 1) * kstep;
            const char* a2 = last ? nA : cA + (size_t)(t + 2) * kstep; const char* b2 = last ? nB : cB + (size_t)(t + 2) * kstep;
            const char* a3 = a2 + kstep; const char* b3 = b2 + kstep;
            if (last && has_next) S.a_ready(nxt);
            if constexpr (SP2) {
            PG8_LDB(B0, 0, 0); PG8_LDB(B1, 0, 1); PG8_SCHED; PG8_LDA(At, 0, 0); PG8_STAGE(PG8_SA(1, 1), a1 + hstepA, voffA);
            PG8_WAIT_V(8); PG8_WAIT_L(0); PG8_BAR; PG8_MMA(0, 0, At, B0); PG8_MMA(0, 1, At, B1); PG8_BAR; PG8_SCHED;
            PG8_LDA(At, 0, 1); PG8_STAGE(PG8_SB(0, 0), b2, voffB); PG8_STAGE(PG8_SB(0, 1), b2 + hstepB, voffB); PG8_STAGE(PG8_SA(0, 0), a2, voffA);
            PG8_WAIT_V(8); PG8_WAIT_L(0); PG8_BAR; PG8_MMA(1, 0, At, B0); PG8_MMA(1, 1, At, B1); PG8_BAR; PG8_SCHED;
            PG8_LDB(B0, 1, 0); PG8_LDB(B1, 1, 1); PG8_SCHED; PG8_LDA(At, 1, 0); PG8_STAGE(PG8_SA(0, 1), a2 + hstepA, voffA);
            PG8_WAIT_V(8); PG8_WAIT_L(0); PG8_BAR; PG8_MMA(0, 0, At, B0); PG8_MMA(0, 1, At, B1); PG8_BAR; PG8_SCHED;
            PG8_LDA(At, 1, 1); PG8_STAGE(PG8_SB(1, 0), b3, voffB); PG8_STAGE(PG8_SB(1, 1), b3 + hstepB, voffB); PG8_STAGE(PG8_SA(1, 0), a3, voffA);
            PG8_WAIT_V(8); PG8_WAIT_L(0); PG8_BAR; PG8_MMA(1, 0, At, B0); PG8_MMA(1, 1, At, B1); PG8_BAR; PG8_SCHED;
            } else {
            PG8_LDB(B0, 0, 0); PG8_SCHED; PG8_LDA(At, 0, 0); PG8_STAGE(PG8_SA(1, 1), a1 + hstepA, voffA);
            PG8_WAIT_L(8); PG8_BAR; PG8_WAIT_L(0); PG8_MMA(0, 0, At, B0); PG8_BAR; PG8_SCHED;
            PG8_LDB(B1, 0, 1); PG8_STAGE(PG8_SB(0, 0), b2, voffB);
            PG8_BAR; PG8_WAIT_L(0); PG8_MMA(0, 1, At, B1); PG8_BAR;
            PG8_LDA(At, 0, 1); PG8_STAGE(PG8_SA(0, 0), a2, voffA);
            PG8_BAR; PG8_WAIT_L(0); PG8_MMA(1, 0, At, B0); PG8_BAR; PG8_SCHED;
            PG8_STAGE(PG8_SB(0, 1), b2 + hstepB, voffB);
            PG8_WAIT_V(6); PG8_BAR; PG8_MMA(1, 1, At, B1); PG8_BAR;
            PG8_LDB(B0, 1, 0); PG8_SCHED; PG8_LDA(At, 1, 0); PG8_STAGE(PG8_SA(0, 1), a2 + hstepA, voffA);
            PG8_WAIT_L(8); PG8_BAR; PG8_WAIT_L(0); PG8_MMA(0, 0, At, B0); PG8_BAR; PG8_SCHED;
            PG8_LDB(B1, 1, 1); PG8_STAGE(PG8_SB(1, 0), b3, voffB);
            PG8_BAR; PG8_WAIT_L(0); PG8_MMA(0, 1, At, B1); PG8_BAR;
            PG8_LDA(At, 1, 1); PG8_STAGE(PG8_SA(1, 0), a3, voffA);
            PG8_BAR; PG8_WAIT_L(0); PG8_MMA(1, 0, At, B0); PG8_BAR; PG8_SCHED;
            PG8_STAGE(PG8_SB(1, 1), b3 + hstepB, voffB);
            PG8_WAIT_V(6); PG8_BAR; PG8_MMA(1, 1, At, B1); PG8_BAR;
            }
        }
        if constexpr (ALIGN_EPI) { if (wr == 0) PG8_BAR; }
        if constexpr (!Epi::AFTER_DRAIN) { E(acc, cur, wr, wc, fr, fq); S.done(cur); }
        if (!has_next) break;
#pragma unroll
        for (int a = 0; a < 2; ++a)
#pragma unroll
            for (int b = 0; b < 2; ++b)
#pragma unroll
                for (int m = 0; m < 4; ++m)
#pragma unroll
                    for (int n = 0; n < 2; ++n) acc[a][b][m][n] = (f32x4){0.f, 0.f, 0.f, 0.f};
        cur = nxt; cA = nA; cB = nB; ++ui;
        if constexpr (ALIGN_EPI) { if (wr == 1) PG8_BAR; }
    }
    PG8_WAIT_V(0);
    if constexpr (!ALIGN_EPI) { if (wr == 0) PG8_BAR; }
    PG8_BAR;
    if constexpr (Epi::AFTER_DRAIN) { E.fused(acc, cur, wr, wc, fr, fq, lds, wid, lane); S.done(cur); }
#undef PG8_SA
#undef PG8_SB
#undef PG8_STAGE
#undef PG8_LDA
#undef PG8_LDB
#undef PG8_MMA
#undef PG8_WAIT_V
#undef PG8_WAIT_L
#undef PG8_BAR
#undef PG8_SCHED
}
}

constexpr size_t MiB = 1u << 20;
constexpr size_t WS_CTL = 0, WS_PCNT = 16384, CTL_BYTES = 32768;
constexpr size_t WS_WIN = 1 * MiB;
constexpr size_t WS_WG = 5 * MiB;
constexpr size_t WS_WOUT = 6 * MiB;
constexpr size_t WS_WQKV = 8 * MiB;
constexpr size_t WS_WBO = 14 * MiB;
constexpr size_t WS_WGU0 = 16 * MiB, WS_WGU1 = 27 * MiB;
constexpr size_t WS_WD0 = 38 * MiB, WS_WD1 = WS_WD0 + (size_t)DM * DFF * 2;
constexpr size_t WS_SS = 49 * MiB;
constexpr size_t WS_AGGP = 50 * MiB, WS_AGGH = 52 * MiB, WS_CARRY = 54 * MiB;
constexpr size_t WS_C8 = 57 * MiB;
constexpr size_t WS_XB = 58 * MiB;
constexpr size_t WS_R0 = 90 * MiB;
constexpr size_t WS_R1 = 122 * MiB;
constexpr size_t WS_R2 = 154 * MiB;
constexpr size_t WS_R3 = 186 * MiB;
constexpr size_t WS_END = 250 * MiB;
static_assert(WS_WD1 + (size_t)DM * DFF * 2 <= WS_SS && WS_R0 + (size_t)MTOK * DFF * 2 <= WS_R3 && WS_R3 + (size_t)MTOK * DM * 4 <= WS_END, "d_ws map");

constexpr int NWAVES = 8, NTHREADS = NWAVES * 64;
constexpr int LDS_BYTES = 147456;
constexpr int SCAN_L = 32, SCAN_NC = SEQ / SCAN_L;

__device__ __forceinline__ void transpose_item(const float* W, int K, int N, bf16_t* WT, int mode, int rowoff, const float* g, LAS float* scr, int item, int lane) {
    const int nblk = N / 32, kb = item / nblk, nb = item % nblk, k0 = 64 * kb, n0 = 32 * nb;
    const int drow0 = rowoff + (mode ? 256 * (n0 >> 7) + (n0 & 127) : n0);
    float tv[32];
    const float* wp = W + (size_t)(k0 + (lane >> 5)) * N + n0 + (lane & 31);
#pragma unroll
    for (int i = 0; i < 32; ++i) tv[i] = __builtin_nontemporal_load(wp + (size_t)(2 * i) * N);
    if (g) {
#pragma unroll
        for (int i = 0; i < 32; ++i) tv[i] *= g[k0 + 2 * i + (lane >> 5)]; }
#pragma unroll
    for (int i = 0; i < 32; ++i) scr[(2 * i + (lane >> 5)) * 33 + (lane & 31)] = tv[i];
    asm volatile("s_waitcnt lgkmcnt(0)" ::: "memory");
    const int c = lane & 7;
#pragma unroll
    for (int j = 0; j < 4; ++j) { const int n = (lane >> 3) + 8 * j; const LAS float* s = scr + (8 * c) * 33 + n;
        u32x4 o; o.x = pk_bf16(s[0 * 33], s[1 * 33]); o.y = pk_bf16(s[2 * 33], s[3 * 33]); o.z = pk_bf16(s[4 * 33], s[5 * 33]); o.w = pk_bf16(s[6 * 33], s[7 * 33]);
        *(u32x4*)(WT + (size_t)(drow0 + n) * K + k0 + 8 * c) = o; }
    asm volatile("s_waitcnt lgkmcnt(0)" ::: "memory");
}

struct Params { const float* in[18]; float* out; unsigned char* ws; };

template <int SET>
__device__ __forceinline__ void convert_weights(const Params& p, LAS unsigned char* lds, int gw, int ngw, int wave, int lane) {
    LAS float* scr = (LAS float*)(lds + wave * 16384);
    unsigned char* ws = p.ws;
    constexpr int I_IN = 16 * 64, I_G = 256, I_SQ = 16 * 32, I_QKV = 16 * 96, I_FF = 16 * 88, I_DN = 44 * 32;
    if constexpr (SET == 0) {
        constexpr int NITEMS = I_IN + I_G + I_SQ + 2 * I_FF;
        for (int it = gw; it < NITEMS; it += ngw) {
            int r = it;
            if (r < I_IN) { transpose_item(p.in[3], DM, 2048, (bf16_t*)(ws + WS_WIN), 0, 0, p.in[1], scr, r, lane); continue; } r -= I_IN;
            if (r < I_G) { const int mtx = r >> 5, blk = mtx & 3, isI = mtx >> 2;
                transpose_item((isI ? p.in[8] : p.in[6]) + blk * 65536, 256, 256, (bf16_t*)(ws + WS_WG), 1, 512 * blk + 128 * isI, nullptr, scr, r & 31, lane); continue; } r -= I_G;
            if (r < I_SQ) { transpose_item(p.in[11], DM, DM, (bf16_t*)(ws + WS_WOUT), 0, 0, nullptr, scr, r, lane); continue; } r -= I_SQ;
            { const int isUp = r / I_FF;
                transpose_item(isUp ? p.in[15] : p.in[14], DM, DFF, (bf16_t*)(ws + WS_WGU0), 1, 128 * isUp, p.in[2], scr, r % I_FF, lane); }
        }
    } else if constexpr (SET == 1) {
        constexpr int NITEMS = I_DN + I_QKV + I_SQ + 2 * I_FF;
        for (int it = gw; it < NITEMS; it += ngw) {
            int r = it;
            if (r < I_DN) { transpose_item(p.in[16], DFF, DM, (bf16_t*)(ws + WS_WD0), 0, 0, nullptr, scr, r, lane); continue; } r -= I_DN;
            if (r < I_QKV) { transpose_item(p.in[12], DM, 3072, (bf16_t*)(ws + WS_WQKV), 0, 0, p.in[1] + DM, scr, r, lane); continue; } r -= I_QKV;
            if (r < I_SQ) { transpose_item(p.in[13], DM, DM, (bf16_t*)(ws + WS_WBO), 0, 0, nullptr, scr, r, lane); continue; } r -= I_SQ;
            { const int isUp = r / I_FF;
                transpose_item((isUp ? p.in[15] : p.in[14]) + (size_t)DM * DFF, DM, DFF, (bf16_t*)(ws + WS_WGU1), 1, 128 * isUp, p.in[2] + DM, scr, r % I_FF, lane); }
        }
    } else {
        for (int it = gw; it < I_DN; it += ngw) transpose_item(p.in[16] + (size_t)DM * DFF, DFF, DM, (bf16_t*)(ws + WS_WD1), 0, 0, nullptr, scr, it, lane);
    }
}
__device__ __forceinline__ void prologue(const Params& p, LAS unsigned char* lds, int gw, int ngw, int wave, int lane) {
    unsigned char* ws = p.ws;
    convert_weights<0>(p, lds, gw, ngw, wave, lane);
    if (gw == 0) { float* c8t = (float*)(ws + WS_C8);
        for (int i = lane; i < DM; i += 64) { const float l = p.in[10][i]; c8t[i] = -8.0f * (fmaxf(-l, 0.f) + log1pf(expf(-fabsf(l)))); } }
    const float* x = p.in[0]; bf16_t* xb = (bf16_t*)(ws + WS_XB); float* ssp = (float*)(ws + WS_SS);
    for (int m = 2 * gw; m < MTOK; m += 2 * ngw) {
        const f32x4* xr = (const f32x4*)(x + (size_t)m * DM) + lane; u32x2* o8 = (u32x2*)(xb + (size_t)m * DM) + lane;
        f32x4 v[8]; float s0 = 0.f, s1 = 0.f;
#pragma unroll
        for (int j = 0; j < 8; ++j) v[j] = __builtin_nontemporal_load(xr + 64 * j);
#pragma unroll
        for (int j = 0; j < 4; ++j) { s0 += (v[j].x * v[j].x + v[j].y * v[j].y) + (v[j].z * v[j].z + v[j].w * v[j].w); s1 += (v[4 + j].x * v[4 + j].x + v[4 + j].y * v[4 + j].y) + (v[4 + j].z * v[4 + j].z + v[4 + j].w * v[4 + j].w); }
        s0 = wave_sum(s0); s1 = wave_sum(s1);
#pragma unroll
        for (int j = 0; j < 8; ++j) { u32x2 w; w.x = pk_bf16(v[j].x, v[j].y); w.y = pk_bf16(v[j].z, v[j].w); o8[64 * j] = w; }
        if (lane < 8) ssp[(size_t)m * 4 + lane] = lane == 0 ? s0 : (lane == 4 ? s1 : 0.f);
    }
}

__device__ __forceinline__ void conv_phase(const bf16_t* xbr, const float* cw, const float* cb, bf16_t* xc, int gt, int ngt) {
    constexpr int TCH = 16, NIT = BATCH * (SEQ / TCH) * (DM / 8);
    for (int item = gt; item < NIT; item += ngt) {
        const int c8 = item & 127, tc = item >> 7, b = tc / (SEQ / TCH), t0 = (tc % (SEQ / TCH)) * TCH, ch = 8 * c8;
        float w[4][8], bias[8], xm[3][8];
#pragma unroll
        for (int j = 0; j < 4; ++j) { const f32x4 a = *(const f32x4*)(cw + j * DM + ch), c = *(const f32x4*)(cw + j * DM + ch + 4);
            w[j][0] = a[0]; w[j][1] = a[1]; w[j][2] = a[2]; w[j][3] = a[3]; w[j][4] = c[0]; w[j][5] = c[1]; w[j][6] = c[2]; w[j][7] = c[3]; }
        { const f32x4 a = *(const f32x4*)(cb + ch), c = *(const f32x4*)(cb + ch + 4); bias[0] = a[0]; bias[1] = a[1]; bias[2] = a[2]; bias[3] = a[3]; bias[4] = c[0]; bias[5] = c[1]; bias[6] = c[2]; bias[7] = c[3]; }
        const bf16_t* src = xbr + (size_t)(b * SEQ + t0) * DM + ch; bf16_t* dst = xc + (size_t)(b * SEQ + t0) * DM + ch;
#pragma unroll
        for (int j = 0; j < 3; ++j) {
            u32x4 xw = {0u, 0u, 0u, 0u}; if (t0 > 0) xw = *(const u32x4*)(src - (3 - j) * DM);
            xm[j][0] = bf_lo(xw.x); xm[j][1] = bf_hi(xw.x); xm[j][2] = bf_lo(xw.y); xm[j][3] = bf_hi(xw.y); xm[j][4] = bf_lo(xw.z); xm[j][5] = bf_hi(xw.z); xm[j][6] = bf_lo(xw.w); xm[j][7] = bf_hi(xw.w); }
#pragma unroll 8
        for (int t = 0; t < TCH; ++t) {
            const u32x4 xw = __builtin_nontemporal_load((const u32x4*)(src + (size_t)t * DM));
            float cur[8] = {bf_lo(xw.x), bf_hi(xw.x), bf_lo(xw.y), bf_hi(xw.y), bf_lo(xw.z), bf_hi(xw.z), bf_lo(xw.w), bf_hi(xw.w)};
            float o[8];
#pragma unroll
            for (int e = 0; e < 8; ++e) { o[e] = bias[e] + w[0][e] * xm[0][e] + w[1][e] * xm[1][e] + w[2][e] * xm[2][e] + w[3][e] * cur[e]; xm[0][e] = xm[1][e]; xm[1][e] = xm[2][e]; xm[2][e] = cur[e]; }
            u32x4 ow; ow.x = pk_bf16(o[0], o[1]); ow.y = pk_bf16(o[2], o[3]); ow.z = pk_bf16(o[4], o[5]); ow.w = pk_bf16(o[6], o[7]);
            *(u32x4*)(dst + (size_t)t * DM) = ow;
        }
    }
}

__device__ __forceinline__ void au_unpack(const u32x4 w, f32x4& a, f32x4& u) {
#pragma unroll
    for (int e = 0; e < 4; ++e) { const f32x2 t = unpk_f16(w[e]); a[e] = __builtin_amdgcn_exp2f(t[0] * (1.0f / 1024.0f)); u[e] = t[1]; }
}
constexpr int SCAN_SC = 8, SCAN_NSC = SCAN_NC / SCAN_SC;
__device__ __forceinline__ void scan_pass1_units(const unsigned* au, f32x4* saggP, f32x4* saggH, f32x4* cpreP, f32x4* cpreH, LAS unsigned char* lds, const pg8::StaticOrder& S, int tid) {
    LAS f32x4* sP = (LAS f32x4*)lds; LAS f32x4* sH = sP + 2 * SCAN_SC * 32;
    const int ti = tid >> 8, cl = (tid >> 5) & 7, ql = tid & 31;
    for (int i0 = 0;; i0 += 2) {
        pg8::Unit u; const bool any = S.next(i0, u); if (!any) break;
        const bool mine = S.next(i0 + ti, u);
        const int pm = u.pm, c4 = ((u.pn >> 1) * 256 + (u.pn & 1) * 128) / 4 + ql, ck = pm * SCAN_SC + cl;
        f32x4 P = {1.f, 1.f, 1.f, 1.f}, Hh = {0.f, 0.f, 0.f, 0.f};
        if (mine) { const size_t off = (size_t)ck * SCAN_L * DM + 4 * c4;
#pragma unroll 16
            for (int t = 0; t < SCAN_L; ++t) { f32x4 a, uu; au_unpack(*(const u32x4*)(au + off + (size_t)t * DM), a, uu); Hh = a * Hh + uu; P = P * a; } }
        sP[(ti * SCAN_SC + cl) * 32 + ql] = P; sH[(ti * SCAN_SC + cl) * 32 + ql] = Hh;
        asm volatile("s_waitcnt lgkmcnt(0)" ::: "memory"); __syncthreads();
        f32x4 pP = {1.f, 1.f, 1.f, 1.f}, pH = {0.f, 0.f, 0.f, 0.f};
        for (int j = 0; j < cl; ++j) { const f32x4 p = sP[(ti * SCAN_SC + j) * 32 + ql], h = sH[(ti * SCAN_SC + j) * 32 + ql]; pH = p * pH + h; pP = pP * p; }
        if (mine) { cpreP[(size_t)ck * 256 + c4] = pP; cpreH[(size_t)ck * 256 + c4] = pH;
            if (cl == SCAN_SC - 1) { saggP[(size_t)pm * 256 + c4] = pP * P; saggH[(size_t)pm * 256 + c4] = P * pH + Hh; } }
        asm volatile("s_waitcnt lgkmcnt(0)" ::: "memory"); __syncthreads();
    }
}
__device__ __forceinline__ void scan_pass2_tile(const unsigned* au, const f32x4* saggP, const f32x4* saggH, const f32x4* cpreP, const f32x4* cpreH, const bf16_t* gate, bf16_t* y, int pm, int blk, int tid) {
    const int cl = tid >> 6, ql = tid & 63, b = pm / SCAN_NSC, c4 = blk * 64 + ql, ck = pm * SCAN_SC + cl;
    f32x4 C = {0.f, 0.f, 0.f, 0.f};
    for (int j = b * SCAN_NSC; j < pm; ++j) { const f32x4 p = saggP[(size_t)j * 256 + c4], h = saggH[(size_t)j * 256 + c4]; C = p * C + h; }
    f32x4 Hh = cpreP[(size_t)ck * 256 + c4] * C + cpreH[(size_t)ck * 256 + c4];
    const size_t off = (size_t)ck * SCAN_L * DM + 4 * c4;
#pragma unroll 16
    for (int t = 0; t < SCAN_L; ++t) { const size_t o = off + (size_t)t * DM; f32x4 a, u; au_unpack(__builtin_nontemporal_load((const u32x4*)(au + o)), a, u); const u32x2 gw2 = __builtin_nontemporal_load((const u32x2*)(gate + o));
        Hh = a * Hh + u;
        u32x2 w; w.x = pk_bf16(Hh[0] * bf_lo(gw2.x), Hh[1] * bf_hi(gw2.x)); w.y = pk_bf16(Hh[2] * bf_lo(gw2.y), Hh[3] * bf_hi(gw2.y));
        *(u32x2*)(y + o) = w; }
}
__device__ __forceinline__ int crow16(int i, int h) { return (i & 3) + 8 * (i >> 2) + 4 * h; }
#define ATT_LOAD(KF, VF, kbi) do { const bf16_t* kp_ = kfrag + (size_t)(kbi) * 2048; const bf16_t* vp_ = vfrag + (size_t)(kbi) * 2048; \
    _Pragma("unroll") for (int s_ = 0; s_ < 4; ++s_) { KF[s_] = *(const bf16x8*)(kp_ + s_ * 512); VF[s_] = *(const bf16x8*)(vp_ + s_ * 512); } } while (0)
#define ATT_STEP(KF, VF, DIAG) do { \
    f32x16 pz; _Pragma("unroll") for (int i_ = 0; i_ < 16; ++i_) pz[i_] = 0.f; \
    _Pragma("unroll") for (int s_ = 0; s_ < 4; ++s_) pz = __builtin_amdgcn_mfma_f32_32x32x16_bf16(KF[s_], qf[s_], pz, 0, 0, 0); \
    float beta[16], f[16]; \
    _Pragma("unroll") for (int i_ = 0; i_ < 16; ++i_) { \
        const float bt_ = __builtin_amdgcn_rcpf(1.0f + __builtin_amdgcn_exp2f(-pz[i_]));     \
        const bool dead_ = (DIAG) && (crow16(i_, h) >= r);                                   \
        beta[i_] = dead_ ? 0.f : bt_; f[i_] = 1.0f - beta[i_]; } \
    float w[16]; float accp = R; \
    _Pragma("unroll") for (int g_ = 3; g_ >= 0; --g_) { \
        const float G_ = (f[4 * g_] * f[4 * g_ + 1]) * (f[4 * g_ + 2] * f[4 * g_ + 3]); \
        const auto rr_ = __builtin_amdgcn_permlane32_swap(__float_as_uint(G_), __float_as_uint(G_), false, false); \
        const float glo_ = __uint_as_float(rr_[0]), ghi_ = __uint_as_float(rr_[1]);          \
        float E_ = h ? accp : accp * ghi_; \
        accp = accp * (glo_ * ghi_); \
        w[4 * g_ + 3] = beta[4 * g_ + 3] * E_; E_ *= f[4 * g_ + 3]; \
        w[4 * g_ + 2] = beta[4 * g_ + 2] * E_; E_ *= f[4 * g_ + 2]; \
        w[4 * g_ + 1] = beta[4 * g_ + 1] * E_; E_ *= f[4 * g_ + 1]; \
        w[4 * g_] = beta[4 * g_] * E_; } \
    R = accp; \
    _Pragma("unroll") for (int s_ = 0; s_ < 2; ++s_) { \
        u32x4 t_; t_.x = pk_bf16(w[8 * s_], w[8 * s_ + 1]); t_.y = pk_bf16(w[8 * s_ + 2], w[8 * s_ + 3]); t_.z = pk_bf16(w[8 * s_ + 4], w[8 * s_ + 5]); t_.w = pk_bf16(w[8 * s_ + 6], w[8 * s_ + 7]); \
        const bf16x8 pw_ = __builtin_bit_cast(bf16x8, t_); \
        o0 = __builtin_amdgcn_mfma_f32_32x32x16_bf16(VF[s_], pw_, o0, 0, 0, 0); \
        o1 = __builtin_amdgcn_mfma_f32_32x32x16_bf16(VF[2 + s_], pw_, o1, 0, 0, 0); } } while (0)
__device__ __forceinline__ void attn_phase(const bf16_t* Q, const bf16_t* K, const bf16_t* VT, bf16_t* O, int gw, int ngw, int lane) {
    const int r = lane & 31, h = lane >> 5;
    constexpr int NQB = SEQ / 32;
    for (int unit = gw; unit < BATCH * NHEAD * NQB; unit += ngw) {
        const int bh = unit / NQB, qb = unit % NQB, b = bh / NHEAD, hd = bh % NHEAD;
        const bf16_t* qp = Q + ((size_t)(bh * NQB + qb) * 256 + lane) * 8;
        bf16x8 qf[4];
#pragma unroll
        for (int s = 0; s < 4; ++s) qf[s] = __builtin_nontemporal_load((const bf16x8*)(qp + s * 512));
        const bf16_t* kfrag = K + ((size_t)bh * NQB * 256 + lane) * 8;
        const bf16_t* vfrag = VT + ((size_t)bh * NQB * 256 + lane) * 8;
        f32x16 o0, o1;
#pragma unroll
        for (int i = 0; i < 16; ++i) { o0[i] = 0.f; o1[i] = 0.f; }
        float R = 1.0f;
        bf16x8 kA[4], vA[4], kB[4], vB[4];
        ATT_LOAD(kA, vA, qb);
        for (int kb = qb;;) {
            ATT_LOAD(kB, vB, kb > 0 ? kb - 1 : 0);
            ATT_STEP(kA, vA, kb == qb);
            if (kb == 0 || !__any(R >= 1.17549435e-38f)) break;
            --kb;
            ATT_LOAD(kA, vA, kb > 0 ? kb - 1 : 0);
            ATT_STEP(kB, vB, false);
            if (kb == 0 || !__any(R >= 1.17549435e-38f)) break;
            --kb;
        }
        bf16_t* op = O + (size_t)(b * SEQ + qb * 32 + r) * DM + hd * HDIM + 4 * h;
#pragma unroll
        for (int g = 0; g < 4; ++g) {
            u32x2 w0; w0.x = pk_bf16(o0[4 * g], o0[4 * g + 1]); w0.y = pk_bf16(o0[4 * g + 2], o0[4 * g + 3]);
            u32x2 w1; w1.x = pk_bf16(o1[4 * g], o1[4 * g + 1]); w1.y = pk_bf16(o1[4 * g + 2], o1[4 * g + 3]);
            *(u32x2*)(op + 8 * g) = w0; *(u32x2*)(op + 32 + 8 * g) = w1;
        }
    }
}
#undef ATT_LOAD
#undef ATT_STEP

__device__ __forceinline__ void final_norm(float* x, const float* ssp, const float* g, int gw, int ngw, int lane) {
    f32x4 gv[4];
#pragma unroll
    for (int j = 0; j < 4; ++j) gv[j] = *((const f32x4*)g + lane + 64 * j);
    for (int m = gw; m < MTOK; m += ngw) {
        const float rs = row_rs(ssp, m);
        f32x4* xr = (f32x4*)(x + (size_t)m * DM) + lane;
#pragma unroll
        for (int j = 0; j < 4; ++j) xr[64 * j] = xr[64 * j] * rs * gv[j];
    }
}


#define XB_TMO      128
#define XB_XCNT(j)  (256  + 64 * (j))
#define XB_XSUB(j)  (1280 + 64 * (j))
#define XB_XGEN(j)  (2304 + 64 * (j))
#define XB_TOP      3328
#define XB_TOPGEN   3392
#define XCD_BAR_WORDS 3456
#define XB_SPIN_CAP (1u << 22)
__device__ __forceinline__ unsigned xb_ld(unsigned* p)              { return __hip_atomic_load(p, __ATOMIC_RELAXED, __HIP_MEMORY_SCOPE_AGENT); }
__device__ __forceinline__ unsigned xb_add(unsigned* p, unsigned v) { return __hip_atomic_fetch_add(p, v, __ATOMIC_RELAXED, __HIP_MEMORY_SCOPE_AGENT); }
__device__ __forceinline__ unsigned xb_xcc_id() { return (unsigned)__builtin_amdgcn_s_getreg((3 << 11) | 20) & 0xFu; }
#define XB_SPIN(cond, bar) do { unsigned _sp = 0; while (cond) { __builtin_amdgcn_s_sleep(1); \
    if ((++_sp & 255u) == 0u) { if (xb_ld(&(bar)[XB_TMO])) break; if (_sp > XB_SPIN_CAP) { atomicAdd(&(bar)[XB_TMO], 1u); break; } } } } while (0)
struct XcdBarrier { unsigned* bar; unsigned x; volatile LAS unsigned* st; };
__device__ __forceinline__ XcdBarrier xcd_barrier_post(unsigned* bar, volatile LAS unsigned* st, bool leader) {
    XcdBarrier b; b.bar = bar; b.x = xb_xcc_id(); b.st = st;
    if (leader) (void)xb_add(&bar[XB_XCNT(b.x)], 1u);
    return b;
}
__device__ __forceinline__ void xcd_barrier_complete(unsigned* bar, unsigned x, unsigned& nloc, unsigned& nx) {
    const unsigned G = gridDim.x * gridDim.y * gridDim.z;
    unsigned sum, cnt, mine, sp = 0u;
    for (;;) {
        sum = 0u; cnt = 0u; mine = 0u;
#pragma unroll
        for (unsigned j = 0; j < 16; ++j) { const unsigned c = xb_ld(&bar[XB_XCNT(j)]); sum += c; cnt += (c > 0u) ? 1u : 0u; mine = (j == x) ? c : mine; }
        if (sum == G) break;
        __builtin_amdgcn_s_sleep(1);
        if ((++sp & 255u) == 0u) { if (xb_ld(&bar[XB_TMO])) break; if (sp > XB_SPIN_CAP) { atomicAdd(&bar[XB_TMO], 1u); break; } }
    }
    nloc = mine > 0u ? mine : 1u; nx = cnt > 0u ? cnt : 1u;
}
__device__ __forceinline__ void xcd_barrier(const XcdBarrier& b, bool leader) {
    asm volatile("s_waitcnt vmcnt(0)" ::: "memory");
    __syncthreads();
    if (leader) {
        unsigned* bar = b.bar;
        __builtin_amdgcn_s_waitcnt(0);
        unsigned nloc = b.st[0], nx = b.st[1];
        if (nloc == 0u) { xcd_barrier_complete(bar, b.x, nloc, nx); b.st[0] = nloc; b.st[1] = nx; }
        const unsigned old = xb_add(&bar[XB_XSUB(b.x)], 1u);
        const unsigned gen = old / nloc;
        if (old + 1u == (gen + 1u) * nloc) {
            __builtin_amdgcn_fence(__ATOMIC_RELEASE, "agent");
            asm volatile("s_waitcnt vmcnt(0)" ::: "memory");
            const unsigned og = xb_add(&bar[XB_TOP], 1u);
            const unsigned tg = og / nx;
            if (og + 1u == (tg + 1u) * nx) xb_add(&bar[XB_TOPGEN], 1u);
        }
        XB_SPIN(xb_ld(&bar[XB_TOPGEN]) == gen, bar);
        __builtin_amdgcn_fence(__ATOMIC_ACQUIRE, "agent");
        asm volatile("s_waitcnt vmcnt(0)" ::: "memory");
    }
    __syncthreads();
}

constexpr int RST_OFF = 131072;
__device__ __forceinline__ int fill_rs_table(LAS unsigned char* lds, const float* ssp, const pg8::StaticOrder& S, int tid) {
    pg8::Unit u0; const int row_base = S.next(0, u0) ? (u0.pm / pg8::WGM) * pg8::WGM * pg8::BM : 0;
    LAS float* rst = (LAS float*)(lds + RST_OFF);
    for (int i = tid; i < pg8::WGM * pg8::BM; i += NTHREADS) rst[i] = row_rs(ssp, row_base + i);
    asm volatile("s_waitcnt lgkmcnt(0)" ::: "memory"); __syncthreads();
    return row_base;
}

__global__ void __launch_bounds__(NTHREADS, 2) fwd_megakernel(Params p) {
    extern __shared__ __attribute__((aligned(16))) unsigned char lds_raw[];
    LAS unsigned char* lds = (LAS unsigned char*)lds_raw;
    cg::grid_group grid = cg::this_grid();
    const int wave = __builtin_amdgcn_readfirstlane(threadIdx.x >> 6);
    const int G = gridDim.x, bx = blockIdx.x;
    const int vcu = (G % 8 == 0) ? (bx % 8) * (G / 8) + bx / 8 : bx;
    const int gw = vcu * NWAVES + wave, ngw = G * NWAVES, ngt = G * NTHREADS;
#define GT() (vcu * NTHREADS + wave * 64 + fresh_lane())
    unsigned char* ws = p.ws;
    volatile LAS unsigned* bst = (volatile LAS unsigned*)(lds + LDS_BYTES - 64);
    const bool leader = (wave == 0) && (fresh_lane() == 0);
    if (leader) { bst[0] = 0u; bst[1] = 0u; }
    XcdBarrier xbar = xcd_barrier_post((unsigned*)(ws + WS_CTL), bst, leader);
#define GSYNC() xcd_barrier(xbar, (wave == 0) && (fresh_lane() == 0))
    float* ssp = (float*)(ws + WS_SS);
    bf16_t* XB = (bf16_t*)(ws + WS_XB);
    bf16_t* R0 = (bf16_t*)(ws + WS_R0); bf16_t* R1 = (bf16_t*)(ws + WS_R1); bf16_t* R2 = (bf16_t*)(ws + WS_R2); bf16_t* R3 = (bf16_t*)(ws + WS_R3);
    unsigned* AU = (unsigned*)(ws + WS_R3);

    prologue(p, lds, gw, ngw, wave, fresh_lane());
    if (p.ws == nullptr) grid.sync();
    GSYNC();

    {   pg8::Gemm g{XB, (const bf16_t*)(ws + WS_WIN), MTOK, 2048, DM, DM, DM, 0}; pg8::StaticOrder S; S.init(MTOK, 2048, G, bx);
        const int rb = fill_rs_table(lds, ssp, S, wave * 64 + fresh_lane());
        pg8::EpiInProj E{R0, R1, (const LAS float*)(lds + RST_OFF), rb};
        pg8::gemm_phase<pg8::EpiInProj, pg8::StaticOrder, true, true>(lds, g, S, E, wave); }
    GSYNC();
    conv_phase(R1, p.in[4], p.in[5], R2, GT(), ngt);
    GSYNC();
    {   pg8::Gemm g{R2, (const bf16_t*)(ws + WS_WG), MTOK, 2048, 256, DM, 256, 1}; pg8::StaticOrder S; S.init(MTOK, 2048, G, bx);
        pg8::EpiGates E{R2, p.in[7], p.in[9], (const float*)(ws + WS_C8), AU};
        pg8::gemm_phase<pg8::EpiGates, pg8::StaticOrder, true, true>(lds, g, S, E, wave);
        asm volatile("s_waitcnt vmcnt(0)" ::: "memory"); __syncthreads();
        scan_pass1_units(AU, (f32x4*)(ws + WS_AGGP), (f32x4*)(ws + WS_AGGP + 512 * 1024), (f32x4*)(ws + WS_AGGH), (f32x4*)(ws + WS_CARRY), lds, S, wave * 64 + fresh_lane()); }
    GSYNC();
    for (int wi = bx; wi < (MTOK / 256) * 4; wi += G)
        scan_pass2_tile(AU, (const f32x4*)(ws + WS_AGGP), (const f32x4*)(ws + WS_AGGP + 512 * 1024), (const f32x4*)(ws + WS_AGGH), (const f32x4*)(ws + WS_CARRY), R0, R1, wi >> 2, wi & 3, wave * 64 + fresh_lane());
    GSYNC();
    {   pg8::Gemm g{R1, (const bf16_t*)(ws + WS_WOUT), MTOK, DM, DM, DM, DM, 0}; pg8::StaticOrder S; S.init(MTOK, DM, G, bx);
        pg8::EpiResid E{XB, ssp};
        pg8::gemm_phase<pg8::EpiResid, pg8::StaticOrder, false, true>(lds, g, S, E, wave); }
    GSYNC();
#pragma unroll
    for (int layer = 0; layer < 2; ++layer) {
        {   pg8::Gemm g{XB, (const bf16_t*)(ws + (layer ? WS_WGU1 : WS_WGU0)), MTOK, 2 * DFF, DM, DM, DM, 0}; pg8::StaticOrder S; S.init(MTOK, 2 * DFF, G, bx);
            const int rb = fill_rs_table(lds, ssp, S, wave * 64 + fresh_lane());
            pg8::EpiSwiglu E{R0, (const LAS float*)(lds + RST_OFF), rb};
            pg8::gemm_phase<pg8::EpiSwiglu, pg8::StaticOrder, true, true>(lds, g, S, E, wave);
            {   pg8::Unit ul; const int rounds = (S.nwg + G - 1) / G;
                if (S.nwg % G != 0 && !S.next(rounds - 1, ul)) { const int nidle = G - S.nwg % G, rank = bx - S.nwg % G;
                    if (layer == 0) convert_weights<1>(p, lds, rank * NWAVES + wave, nidle * NWAVES, wave, fresh_lane());
                    else convert_weights<2>(p, lds, rank * NWAVES + wave, nidle * NWAVES, wave, fresh_lane()); } } }
        GSYNC();
        {   pg8::Gemm g{R0, (const bf16_t*)(ws + (layer ? WS_WD1 : WS_WD0)), MTOK, DM, DFF, DFF, DFF, 0}; pg8::StaticOrder S; S.init(MTOK, DM, G, bx);
            if (layer == 0) { pg8::EpiResid E{XB, ssp}; pg8::gemm_phase<pg8::EpiResid, pg8::StaticOrder, false, true>(lds, g, S, E, wave); }
            else { pg8::EpiFinal E{XB, ssp, (unsigned*)(ws + WS_PCNT), p.in[17], p.out}; pg8::gemm_phase<pg8::EpiFinal, pg8::StaticOrder, false, true>(lds, g, S, E, wave); } }
        if (layer == 0) {
            GSYNC();
            {   pg8::Gemm g{XB, (const bf16_t*)(ws + WS_WQKV), MTOK, 3072, DM, DM, DM, 0, (const bf16_t*)(ws + WS_WQKV) + (size_t)2048 * DM, XB, 8}; pg8::StaticOrder S; S.init(MTOK, 3072, G, bx);
                const int rb = fill_rs_table(lds, ssp, S, wave * 64 + fresh_lane());
                pg8::EpiQKV E{pg8::EpiQK{R0, R1, (const LAS float*)(lds + RST_OFF), rb, 0.125f * LOG2E}, pg8::EpiVT{R2, (const LAS float*)(lds + RST_OFF), rb}};
                pg8::gemm_phase<pg8::EpiQKV, pg8::StaticOrder, true, true>(lds, g, S, E, wave); }
            GSYNC();
            attn_phase(R0, R1, R2, R3, gw, ngw, fresh_lane());
            GSYNC();
            {   pg8::Gemm g{R3, (const bf16_t*)(ws + WS_WBO), MTOK, DM, DM, DM, DM, 0}; pg8::StaticOrder S; S.init(MTOK, DM, G, bx);
                pg8::EpiResid E{XB, ssp};
                pg8::gemm_phase<pg8::EpiResid, pg8::StaticOrder, false, true>(lds, g, S, E, wave); }
            GSYNC();
        }
    }
}

extern "C" void kernel_launch(void* const* d_in, const int* in_sizes, int n_in, void* d_out, int out_size, void* d_ws, size_t ws_size, hipStream_t stream) {
    static int grid = 0;
    if (grid == 0) {
        if (n_in != 18 || out_size != MTOK * DM || ws_size < WS_END) { fprintf(stderr, "kernel_launch: unexpected shapes (n_in %d, out %d, ws %zu)\n", n_in, out_size, ws_size); grid = -1; return; }
        int dev = 0, cus = 0, per_cu = 0;
        (void)hipGetDevice(&dev); (void)hipDeviceGetAttribute(&cus, hipDeviceAttributeMultiprocessorCount, dev);
        if (hipFuncSetAttribute((const void*)fwd_megakernel, hipFuncAttributeMaxDynamicSharedMemorySize, LDS_BYTES) != hipSuccess) { fprintf(stderr, "kernel_launch: hipFuncSetAttribute failed\n"); grid = -1; return; }
        if (hipOccupancyMaxActiveBlocksPerMultiprocessor(&per_cu, (const void*)fwd_megakernel, NTHREADS, LDS_BYTES) != hipSuccess || per_cu < 1) { fprintf(stderr, "kernel_launch: occupancy query says %d blocks per CU\n", per_cu); per_cu = 1; }
        (void)hipGetLastError();
        grid = cus;
        if (grid != 256) fprintf(stderr, "kernel_launch: %d CUs; this kernel is built for 256\n", grid);
    }
    if (grid < 0) return;
    if (hipMemsetAsync((char*)d_ws + WS_CTL, 0, CTL_BYTES, stream) != hipSuccess) { fprintf(stderr, "kernel_launch: hipMemsetAsync failed\n"); return; }
    Params p{};
    for (int i = 0; i < 18; ++i) p.in[i] = (const float*)d_in[i];
    p.out = (float*)d_out; p.ws = (unsigned char*)d_ws;
    void* args[] = {&p};
    const hipError_t e = hipLaunchCooperativeKernel((const void*)fwd_megakernel, dim3(grid), dim3(NTHREADS), args, LDS_BYTES, stream);
    if (e != hipSuccess) fprintf(stderr, "kernel_launch: cooperative launch failed: %s (grid %d)\n", hipGetErrorString(e), grid);
}
```
